# Optimizing an MI355X kernel written in HIP

```python
import jax, jax.numpy as jnp
from jax import lax
import numpy as np

D_MODEL = 2048
BATCH = 8
SEQ = 4096
DEPTH = 4

HEAD_DIM = 128
BLOCK = 128
EPS = 1e-6
ROPE_THETA = 500000.0
PARTIAL_ROPE = HEAD_DIM // 4
FOX_HEADS = (D_MODEL // 4) // HEAD_DIM
FOX_W = FOX_HEADS * HEAD_DIM
FORGET_BIAS_CENTER = 2.0
MLA_HEADS = (D_MODEL // 2) // HEAD_DIM
MLA_Q_RANK = D_MODEL // 4
MLA_KV_RANK = D_MODEL // 4
MLA_NOPE = 128
MLA_ROPE = 64
MLA_V = HEAD_DIM
MLA_W = MLA_HEADS * MLA_V
DIL_HEADS = (D_MODEL // 4) // HEAD_DIM
DIL_W = DIL_HEADS * HEAD_DIM
DIL_BRANCHES = ((128, 1), (512, 4), (2048, 16))
MIX_W = FOX_W + MLA_W + DIL_W
IN_SIZES = (FOX_W, FOX_W, FOX_W, FOX_HEADS,
            MLA_Q_RANK, MLA_KV_RANK, MLA_ROPE,
            DIL_W, DIL_W, DIL_W)
IN_W = sum(IN_SIZES)
D_FF = 5632

kernel_name = "hybrid_fox_mla_dilated_macaron"


def rms_norm(x, g):
    xf = x.astype(jnp.float32)
    y = xf * lax.rsqrt(jnp.mean(xf * xf, axis=-1, keepdims=True) + EPS)
    return (y * g.astype(jnp.float32)).astype(x.dtype)


def swiglu(h, w_gate, w_up, w_down):
    return (jax.nn.silu(h @ w_gate) * (h @ w_up)) @ w_down


def rope_tables(seq, dim):
    inv = 1.0 / (ROPE_THETA ** (jnp.arange(0, dim, 2, dtype=jnp.float32) / dim))
    ang = jnp.arange(seq, dtype=jnp.float32)[:, None] * inv[None, :]
    return jnp.cos(ang), jnp.sin(ang)


def apply_rope(x, cos, sin):
    x1, x2 = jnp.split(x, 2, axis=-1)
    c, s = cos.astype(x.dtype), sin.astype(x.dtype)
    return jnp.concatenate([x1 * c - x2 * s, x1 * s + x2 * c], axis=-1)


def partial_rope(x, cos, sin):
    return jnp.concatenate([apply_rope(x[..., :PARTIAL_ROPE], cos, sin), x[..., PARTIAL_ROPE:]], axis=-1)


def to_heads(t, n_heads):
    b, s, _ = t.shape
    return t.reshape(b, s, n_heads, -1).transpose(0, 2, 1, 3)


def merge_heads(t):
    b, h, s, d = t.shape
    return t.transpose(0, 2, 1, 3).reshape(b, s, h * d)


def causal_block_attention(q, k, v, scale, cum_log_f=None):
    b, h, s_len, _ = q.shape
    nb = s_len // BLOCK
    kpos = jnp.arange(s_len)
    xs = [jnp.arange(nb), q.reshape(b, h, nb, BLOCK, -1).transpose(2, 0, 1, 3, 4)]
    if cum_log_f is not None:
        xs.append(cum_log_f.reshape(b, h, nb, BLOCK).transpose(2, 0, 1, 3))

    def attend(blk):
        i, qi = blk[0], blk[1]
        sc = jnp.einsum("bhqd,bhkd->bhqk", qi, k, preferred_element_type=jnp.float32) * scale
        if cum_log_f is not None:
            sc = sc + (blk[2][..., :, None] - cum_log_f[..., None, :])
        qpos = i * BLOCK + jnp.arange(BLOCK)
        sc = jnp.where(kpos[None, :] <= qpos[:, None], sc, -jnp.inf)
        p = jax.nn.softmax(sc, axis=-1)
        return jnp.einsum("bhqk,bhkd->bhqd", p.astype(v.dtype), v)

    out = lax.map(attend, tuple(xs))
    return out.transpose(1, 2, 0, 3, 4).reshape(b, h, s_len, -1)


def dilated_branch(q, k, v, window, dilation):
    b, h, s_len, hd = q.shape
    L = s_len // dilation
    n_back = window // dilation
    Lp = -(-L // BLOCK) * BLOCK
    nb = Lp // BLOCK

    def to_blocks(t):
        t = t.reshape(b, h, L, dilation, hd).transpose(0, 1, 3, 2, 4)
        t = jnp.pad(t, ((0, 0), (0, 0), (0, 0), (0, Lp - L), (0, 0)))
        return t.reshape(b, h, dilation, nb, BLOCK, hd)

    def with_prev(t):
        prev = jnp.pad(t, ((0, 0), (0, 0), (0, 0), (1, 0), (0, 0), (0, 0)))[:, :, :, :-1]
        return jnp.concatenate([prev, t], axis=4)

    qb = to_blocks(q)
    kc = with_prev(to_blocks(k))
    vc = with_prev(to_blocks(v))
    sc = jnp.einsum("bhrnqd,bhrnkd->bhrnqk", qb, kc, preferred_element_type=jnp.float32) * (hd ** -0.5)
    kidx = jnp.arange(2 * BLOCK)
    dist = (BLOCK + jnp.arange(BLOCK))[:, None] - kidx[None, :]
    band = (dist >= 0) & (dist <= n_back)
    has_prev = (jnp.arange(nb)[:, None, None] > 0) | (kidx[None, None, :] >= BLOCK)
    sc = jnp.where(band[None] & has_prev, sc, -jnp.inf)
    m = jnp.max(sc, axis=-1, keepdims=True)
    e = jnp.exp(sc - m)
    l = jnp.sum(e, axis=-1, keepdims=True)
    o = jnp.einsum("bhrnqk,bhrnkd->bhrnqd", (e / l).astype(v.dtype), vc)
    lse = (m + jnp.log(l))[..., 0]
    o = o.reshape(b, h, dilation, Lp, hd)[:, :, :, :L].transpose(0, 1, 3, 2, 4).reshape(b, h, s_len, hd)
    lse = lse.reshape(b, h, dilation, Lp)[..., :L].transpose(0, 1, 3, 2).reshape(b, h, s_len)
    return o, lse


def dilated_mixture(q, k, v):
    outs, lses = [], []
    for window, dilation in DIL_BRANCHES:
        o, lse = dilated_branch(q, k, v, window, dilation)
        outs.append(o)
        lses.append(lse)
    wts = jax.nn.softmax(jnp.stack(lses, axis=0), axis=0)
    return jnp.sum(wts[..., None].astype(q.dtype) * jnp.stack(outs, axis=0), axis=0)


def setup_inputs(seed: int = 0) -> dict:
    key = jax.random.key(seed)
    ks = iter(jax.random.split(key, 32))

    def dense(shape, fan_in):
        return jax.random.normal(next(ks), shape, jnp.float32) * (fan_in ** -0.5)

    def gain(shape):
        return 1.0 + 0.02 * jax.random.normal(next(ks), shape, jnp.float32)

    x = jax.random.normal(next(ks), (BATCH, SEQ, D_MODEL), jnp.float32)
    return {
        "x": x,
        "ffn1_norm": gain((DEPTH, D_MODEL)),
        "ffn1_w_gate": dense((DEPTH, D_MODEL, D_FF), D_MODEL),
        "ffn1_w_up": dense((DEPTH, D_MODEL, D_FF), D_MODEL),
        "ffn1_w_down": dense((DEPTH, D_FF, D_MODEL), D_FF),
        "mix_norm": gain((DEPTH, D_MODEL)),
        "w_in": dense((DEPTH, D_MODEL, IN_W), D_MODEL),
        "fox_forget_bias": FORGET_BIAS_CENTER + 0.5 * jax.random.normal(next(ks), (DEPTH, FOX_HEADS), jnp.float32),
        "mla_q_norm": gain((DEPTH, MLA_Q_RANK)),
        "mla_kv_norm": gain((DEPTH, MLA_KV_RANK)),
        "mla_w_uq": dense((DEPTH, MLA_Q_RANK, MLA_HEADS * (MLA_NOPE + MLA_ROPE)), MLA_Q_RANK),
        "mla_w_ukv": dense((DEPTH, MLA_KV_RANK, MLA_HEADS * (MLA_NOPE + MLA_V)), MLA_KV_RANK),
        "w_out": dense((DEPTH, MIX_W, D_MODEL), MIX_W),
        "ffn2_norm": gain((DEPTH, D_MODEL)),
        "ffn2_w_gate": dense((DEPTH, D_MODEL, D_FF), D_MODEL),
        "ffn2_w_up": dense((DEPTH, D_MODEL, D_FF), D_MODEL),
        "ffn2_w_down": dense((DEPTH, D_FF, D_MODEL), D_FF),
        "final_norm": gain((D_MODEL,)),
    }


def reference(x, ffn1_norm, ffn1_w_gate, ffn1_w_up, ffn1_w_down, mix_norm, w_in, fox_forget_bias,
              mla_q_norm, mla_kv_norm, mla_w_uq, mla_w_ukv, w_out, ffn2_norm, ffn2_w_gate, ffn2_w_up,
              ffn2_w_down, final_norm):
    b, s_len, _ = x.shape
    cos_p, sin_p = rope_tables(s_len, PARTIAL_ROPE)
    cos_m, sin_m = rope_tables(s_len, MLA_ROPE)
    offsets = []
    acc = 0
    for size in IN_SIZES[:-1]:
        acc += size
        offsets.append(acc)

    for l in range(DEPTH):
        x = x + 0.5 * swiglu(rms_norm(x, ffn1_norm[l]), ffn1_w_gate[l], ffn1_w_up[l], ffn1_w_down[l])

        h = rms_norm(x, mix_norm[l])
        proj = h @ w_in[l]
        fq, fk, fv, f_logit, c_q, c_kv, k_r, dq, dk, dv = jnp.split(proj, offsets, axis=-1)

        log_f = jax.nn.log_sigmoid((f_logit + fox_forget_bias[l]).astype(jnp.float32))
        cum = jnp.cumsum(log_f, axis=1).transpose(0, 2, 1)
        out_a = causal_block_attention(to_heads(fq, FOX_HEADS), to_heads(fk, FOX_HEADS),
                                       to_heads(fv, FOX_HEADS), HEAD_DIM ** -0.5, cum)

        q_b = to_heads(rms_norm(c_q, mla_q_norm[l]) @ mla_w_uq[l], MLA_HEADS)
        q_b = jnp.concatenate([q_b[..., :MLA_NOPE], apply_rope(q_b[..., MLA_NOPE:], cos_m, sin_m)], axis=-1)
        kv_b = to_heads(rms_norm(c_kv, mla_kv_norm[l]) @ mla_w_ukv[l], MLA_HEADS)
        k_rope = apply_rope(k_r[:, None], cos_m, sin_m)
        k_b = jnp.concatenate([kv_b[..., :MLA_NOPE],
                               jnp.broadcast_to(k_rope, (b, MLA_HEADS, s_len, MLA_ROPE))], axis=-1)
        out_b = causal_block_attention(q_b, k_b, kv_b[..., MLA_NOPE:], (MLA_NOPE + MLA_ROPE) ** -0.5)

        out_c = dilated_mixture(partial_rope(to_heads(dq, DIL_HEADS), cos_p, sin_p),
                                partial_rope(to_heads(dk, DIL_HEADS), cos_p, sin_p),
                                to_heads(dv, DIL_HEADS))

        mixed = jnp.concatenate([merge_heads(out_a), merge_heads(out_b), merge_heads(out_c)], axis=-1)
        x = x + mixed @ w_out[l]

        x = x + 0.5 * swiglu(rms_norm(x, ffn2_norm[l]), ffn2_w_gate[l], ffn2_w_up[l], ffn2_w_down[l])

    return rms_norm(x, final_norm)
```

```cpp
#include <hip/hip_runtime.h>
#include <cstdio>
#include <cstdint>

#ifndef MK_EPI_REP
#define MK_EPI_REP 1
#endif
#define LAS __attribute__((address_space(3)))
#define GAS __attribute__((address_space(1)))
typedef unsigned short bf16_t;
typedef short bf16x8 __attribute__((ext_vector_type(8)));
typedef short s16x4 __attribute__((ext_vector_type(4)));
typedef float f32x4 __attribute__((ext_vector_type(4)));
typedef float f32x2 __attribute__((ext_vector_type(2)));
typedef float f32x16 __attribute__((ext_vector_type(16)));
typedef unsigned u32x4 __attribute__((ext_vector_type(4)));
typedef unsigned u32x2 __attribute__((ext_vector_type(2)));

constexpr int BATCH = 8, SEQ = 4096, DM = 2048, DEPTH = 4, FF = 5632, HD = 128;
constexpr int M = BATCH * SEQ;
constexpr int IN_W = 4164, INP = 4352;
constexpr int NGU = 2 * FF;
constexpr float EPS = 1e-6f;
constexpr float LOG2E = 1.4426950408889634f;
constexpr float C2_FOX = 0.08838834764831845f * LOG2E;
constexpr float C2_DIL = C2_FOX;
constexpr float C2_MLA = 0.07216878364870322f * LOG2E;
constexpr int PP = 4096;
constexpr int PC_FQ = 0, PC_FK = 512, PC_FV = 1024, PC_CQ = 1536, PC_CKV = 2048, PC_DQ = 2560, PC_DK = 3072, PC_DV = 3584;

constexpr size_t MiB = 1u << 20;
constexpr size_t WS_CTL = 0, CTL_ZERO_BYTES = 1 * MiB;
constexpr size_t WS_COSM = 1 * MiB;
constexpr size_t WS_SINM = WS_COSM + 512 * 1024;
constexpr size_t WS_COSP = 2 * MiB;
constexpr size_t WS_SINP = WS_COSP + 256 * 1024;
constexpr size_t WS_SSQ = 4 * MiB;
constexpr size_t WS_SSQQ = 8 * MiB;
constexpr size_t WS_SSQKV = 9 * MiB;
constexpr size_t WS_LOGF = 10 * MiB;
constexpr size_t WS_LSE = 11 * MiB;
constexpr size_t WS_W = 16 * MiB;
constexpr size_t W_GU = (size_t)NGU * DM * 2, W_DN = (size_t)DM * FF * 2, W_IN = (size_t)INP * DM * 2, W_UQ = (size_t)1536 * 512 * 2, W_UKV = (size_t)2048 * 512 * 2, W_OUT = (size_t)DM * DM * 2;
constexpr size_t WO_GU1 = 0, WO_DN1 = WO_GU1 + W_GU, WO_IN = WO_DN1 + W_DN, WO_UQ = WO_IN + W_IN, WO_UKV = WO_UQ + W_UQ, WO_OUT = WO_UKV + W_UKV, WO_GU2 = WO_OUT + W_OUT, WO_DN2 = WO_GU2 + W_GU, W_LAYER = WO_DN2 + W_DN;
constexpr size_t WS_XB = WS_W + DEPTH * W_LAYER;
constexpr size_t WS_BIG = WS_XB + (size_t)M * DM * 2;
constexpr size_t WS_P = WS_BIG;
constexpr size_t WS_KR = WS_P + (size_t)M * PP * 2;
constexpr size_t WS_QBN = WS_KR + (size_t)M * 64 * 2;
constexpr size_t WS_QBR = WS_QBN + (size_t)M * 1024 * 2;
constexpr size_t WS_KVB = WS_QBR + (size_t)M * 512 * 2;
constexpr size_t WS_MIX = WS_KVB + (size_t)M * 2048 * 2;
constexpr size_t WS_DILO = WS_MIX + (size_t)M * 2048 * 2;
constexpr size_t WS_END = WS_DILO + (size_t)2 * M * 512 * 2;
static_assert(W_LAYER % 256 == 0 && WS_BIG + (size_t)M * FF * 2 <= WS_END, "ws map");

constexpr int CW_BAR = 4096;

__device__ __forceinline__ unsigned cvt_pk_bf16(float lo, float hi) { unsigned r; asm volatile("v_cvt_pk_bf16_f32 %0, %1, %2" : "=v"(r) : "v"(lo), "v"(hi)); return r; }
__device__ __forceinline__ float bf2f(unsigned short h) { return __uint_as_float((unsigned)h << 16); }
#define LDS_WAIT() asm volatile("s_waitcnt lgkmcnt(0)" ::: "memory")
#define VM_WAIT() asm volatile("s_waitcnt vmcnt(0)" ::: "memory")

namespace pg8 {
constexpr int BM = 256, BK = 64, HALF = 128, HTB = HALF * BK * 2, STAGE_BYTES = 8 * HTB, NXCD = 8, WGM = 8;
__host__ __device__ __forceinline__ int lds_byte(int r, int c) { const int st = (r >> 4) * 2 + (c >> 5), rr = r & 15, cc = c & 31, ob = rr * 64 + cc * 2; return st * 1024 + (ob ^ (((ob >> 9) & 1) << 5)); }
__host__ __device__ __forceinline__ void stage_rc(int b, int& R, int& C) { const int st = b / 1024, sb = b % 1024, swz = sb ^ (((sb >> 9) & 1) << 5); R = (st >> 1) * 16 + swz / 64; C = (st & 1) * 32 + (swz % 64) / 2; }
__host__ __device__ __forceinline__ int perm32(int rho) { const int n = rho >> 4, i = rho & 15; return 8 * (i >> 2) + 4 * n + (i & 3); }
struct Unit { int pm, pn; };
struct Gemm { const bf16_t* A; const bf16_t* Bt; int lda, ldb, M, N, K; int kstepA = BK * 2, tstepA = 0; };
struct StaticOrder {
    int nM, nN, nwg, G, c, wgm;
    __host__ __device__ void init(int M_, int N_, int G_, int c_, int wgm_ = WGM) { nM = M_ / BM; nN = N_ / BM; nwg = nM * nN; G = G_; c = c_; wgm = wgm_; }
    __host__ __device__ bool next(int i, Unit& u) const {
        const long L = (long)i * G + c; if (L >= nwg) return false;
        int wgid = (int)L; { const int q = nwg / NXCD, r = nwg % NXCD, xcd = wgid % NXCD, off = wgid / NXCD; wgid = (xcd < r ? xcd * (q + 1) : r * (q + 1) + (xcd - r) * q) + off; }
        const int nig = wgm * nN, gid = wgid / nig, fm = gid * wgm, gsz = (nM - fm) < wgm ? (nM - fm) : wgm;
        u.pm = fm + ((wgid % nig) % gsz); u.pn = (wgid % nig) / gsz; return true;
    }
};
template <class Epi, bool ALIGN_EPI>
__device__ __forceinline__ void gemm_phase(LAS unsigned char* lds, const Gemm g, const StaticOrder& S, const Epi& E) {
    int tid_o = threadIdx.x; asm volatile("" : "+v"(tid_o));
    const int tid = tid_o, wid = __builtin_amdgcn_readfirstlane(tid >> 6), lane = tid & 63, wr = wid >> 2, wc = wid & 3, fr = lane & 15, fq = lane >> 4;
    const int K = g.K, nt = K / BK;
    unsigned voffA[2], voffB[2];
#pragma unroll
    for (int i = 0; i < 2; ++i) { int R, C; stage_rc(tid * 16 + i * 8192, R, C); const int Rb = Epi::PERM ? ((R & ~31) + perm32(R & 31)) : R;
        voffA[i] = (unsigned)(R * g.lda + C) * 2u; voffB[i] = (unsigned)(Rb * g.ldb + C) * 2u; }
    const size_t kstep = (size_t)(BK * 2), kstepA = (size_t)g.kstepA;
    const size_t hstepA = (size_t)HALF * g.lda * 2, hstepB = (size_t)HALF * g.ldb * 2;
    const size_t tstepA = g.tstepA ? (size_t)g.tstepA : 2 * hstepA, tstepB = 2 * hstepB;
    const unsigned ldsw = (unsigned)wid * 1024u;
    const __amdgpu_buffer_rsrc_t srdA = __builtin_amdgcn_make_buffer_rsrc((void*)g.A, (short)0, 0x7fffffff, 0x00020000), srdB = __builtin_amdgcn_make_buffer_rsrc((void*)g.Bt, (short)0, 0x7fffffff, 0x00020000);
    const int aoff = lds_byte(wr * 64 + fr, fq * 8), boff = lds_byte(wc * 32 + fr, fq * 8);
#define PG8_SA(b, h) (((b) * 2 + (h)) * HTB)
#define PG8_SB(b, h) ((4 + (b) * 2 + (h)) * HTB)
#define PG8_STAGE(srd, base0, bufoff, gbase, voff) do { const unsigned so_ = (unsigned)((const char*)(gbase) - (const char*)(base0)); _Pragma("unroll") for (int _i = 0; _i < 2; ++_i) \
        __builtin_amdgcn_raw_ptr_buffer_load_lds(srd, (LAS void*)(lds + (bufoff) + ldsw + _i * 8192), 16, (int)(voff)[_i], (int)so_, 0, 0); } while (0)
#define PG8_LDA(dst, b, h) do { _Pragma("unroll") for (int m = 0; m < 4; ++m) _Pragma("unroll") for (int k = 0; k < 2; ++k) dst[m][k] = *(const LAS bf16x8*)(lds + PG8_SA(b, h) + aoff + m * 2048 + k * 1024); } while (0)
#define PG8_LDB(dst, b, h) do { _Pragma("unroll") for (int n = 0; n < 2; ++n) _Pragma("unroll") for (int k = 0; k < 2; ++k) dst[n][k] = *(const LAS bf16x8*)(lds + PG8_SB(b, h) + boff + n * 2048 + k * 1024); } while (0)
#define PG8_MMA(ai, bj, At, Bt) do { __builtin_amdgcn_s_setprio(1); _Pragma("unroll") for (int m = 0; m < 4; ++m) _Pragma("unroll") for (int n = 0; n < 2; ++n) _Pragma("unroll") for (int k = 0; k < 2; ++k) \
        acc[ai][bj][m][n] = __builtin_amdgcn_mfma_f32_16x16x32_bf16(Bt[n][k], At[m][k], acc[ai][bj][m][n], 0, 0, 0); __builtin_amdgcn_s_setprio(0); } while (0)
#define PG8_WAIT_V(n) asm volatile("s_waitcnt vmcnt(" #n ")" ::: "memory")
#define PG8_WAIT_L(n) asm volatile("s_waitcnt lgkmcnt(" #n ")" ::: "memory")
#define PG8_BAR __builtin_amdgcn_s_barrier()
#define PG8_SCHED __builtin_amdgcn_sched_barrier(0)
    Unit cur, nxt; int ui = 0;
    if (!S.next(0, cur)) return;
    __builtin_amdgcn_s_waitcnt(0x0F70);
    LAS float* rc = (LAS float*)(lds + STAGE_BYTES + 1024) + wid * 144;
    *(volatile LAS int*)(rc + 128) = -1;
    f32x4 acc[2][2][4][2];
#pragma unroll
    for (int a = 0; a < 2; ++a)
#pragma unroll
        for (int b = 0; b < 2; ++b)
#pragma unroll
            for (int m = 0; m < 4; ++m)
#pragma unroll
                for (int n = 0; n < 2; ++n) acc[a][b][m][n] = (f32x4){0.f, 0.f, 0.f, 0.f};
    bf16x8 At[4][2], B0[2][2], B1[2][2];
    const char* cA = (const char*)g.A + (size_t)cur.pm * tstepA; const char* cB = (const char*)g.Bt + (size_t)cur.pn * tstepB;
    PG8_STAGE(srdB, g.Bt, PG8_SB(0, 0), cB, voffB); PG8_STAGE(srdB, g.Bt, PG8_SB(0, 1), cB + hstepB, voffB); PG8_STAGE(srdA, g.A, PG8_SA(0, 0), cA, voffA); PG8_STAGE(srdA, g.A, PG8_SA(0, 1), cA + hstepA, voffA);
    if (wr == 1) PG8_BAR;
    PG8_WAIT_V(2); PG8_BAR;
    PG8_STAGE(srdB, g.Bt, PG8_SB(1, 0), cB + kstep, voffB); PG8_STAGE(srdA, g.A, PG8_SA(1, 0), cA + kstepA, voffA); PG8_STAGE(srdB, g.Bt, PG8_SB(1, 1), cB + hstepB + kstep, voffB);
    PG8_WAIT_V(6); PG8_BAR;
    for (;;) {
        const bool has_next = S.next(ui + 1, nxt);
        const char* nA = has_next ? (const char*)g.A + (size_t)nxt.pm * tstepA : cA; const char* nB = has_next ? (const char*)g.Bt + (size_t)nxt.pn * tstepB : cB;
        for (int t = 0; t < nt; t += 2) {
            const bool last = (t == nt - 2);
            const char* a1 = cA + (size_t)(t + 1) * kstepA;
            const char* a2 = last ? nA : cA + (size_t)(t + 2) * kstepA; const char* b2 = last ? nB : cB + (size_t)(t + 2) * kstep;
            const char* a3 = a2 + kstepA; const char* b3 = b2 + kstep;
            PG8_LDB(B0, 0, 0); PG8_LDB(B1, 0, 1); PG8_SCHED; PG8_LDA(At, 0, 0); PG8_STAGE(srdA, g.A, PG8_SA(1, 1), a1 + hstepA, voffA);
            PG8_WAIT_V(8); PG8_WAIT_L(0); PG8_BAR; PG8_MMA(0, 0, At, B0); PG8_MMA(0, 1, At, B1); PG8_BAR; PG8_SCHED;
            PG8_LDA(At, 0, 1); PG8_STAGE(srdB, g.Bt, PG8_SB(0, 0), b2, voffB); PG8_STAGE(srdB, g.Bt, PG8_SB(0, 1), b2 + hstepB, voffB); PG8_STAGE(srdA, g.A, PG8_SA(0, 0), a2, voffA);
            PG8_WAIT_V(8); PG8_WAIT_L(0); PG8_BAR; PG8_MMA(1, 0, At, B0); PG8_MMA(1, 1, At, B1); PG8_BAR; PG8_SCHED;
            PG8_LDB(B0, 1, 0); PG8_LDB(B1, 1, 1); PG8_SCHED; PG8_LDA(At, 1, 0); PG8_STAGE(srdA, g.A, PG8_SA(0, 1), a2 + hstepA, voffA);
            PG8_WAIT_V(8); PG8_WAIT_L(0); PG8_BAR; PG8_MMA(0, 0, At, B0); PG8_MMA(0, 1, At, B1); PG8_BAR; PG8_SCHED;
            PG8_LDA(At, 1, 1); PG8_STAGE(srdB, g.Bt, PG8_SB(1, 0), b3, voffB); PG8_STAGE(srdB, g.Bt, PG8_SB(1, 1), b3 + hstepB, voffB); PG8_STAGE(srdA, g.A, PG8_SA(1, 0), a3, voffA);
            PG8_WAIT_V(8); PG8_WAIT_L(0); PG8_BAR; PG8_MMA(1, 0, At, B0); PG8_MMA(1, 1, At, B1); PG8_BAR; PG8_SCHED;
        }
        if constexpr (ALIGN_EPI) { if (wr == 0) PG8_BAR; }
        E(acc, cur, wr, wc, fr, fq, rc);
        if constexpr (Epi::EREP > 1) { for (int er_ = 1; er_ < Epi::EREP; ++er_) { asm volatile("" ::: "memory"); E(acc, cur, wr, wc, fr, fq, rc); } }
        if (!has_next) break;
#pragma unroll
        for (int a = 0; a < 2; ++a)
#pragma unroll
            for (int b = 0; b < 2; ++b)
#pragma unroll
                for (int m = 0; m < 4; ++m)
#pragma unroll
                    for (int n = 0; n < 2; ++n) acc[a][b][m][n] = (f32x4){0.f, 0.f, 0.f, 0.f};
        cur = nxt; cA = nA; cB = nB; ++ui;
        if constexpr (ALIGN_EPI) { if (wr == 1) PG8_BAR; }
    }
    PG8_WAIT_V(0);
    if constexpr (!ALIGN_EPI) { if (wr == 0) PG8_BAR; }
    PG8_BAR;
#undef PG8_SA
#undef PG8_SB
#undef PG8_STAGE
#undef PG8_LDA
#undef PG8_LDB
#undef PG8_MMA
#undef PG8_WAIT_V
#undef PG8_WAIT_L
#undef PG8_BAR
#undef PG8_SCHED
}

__device__ __forceinline__ float xrow16_sum(float x) {
    auto s = __builtin_amdgcn_permlane16_swap(__float_as_uint(x), __float_as_uint(x), false, false);
    x = __uint_as_float(s[0]) + __uint_as_float(s[1]);
    auto t = __builtin_amdgcn_permlane32_swap(__float_as_uint(x), __float_as_uint(x), false, false);
    return __uint_as_float(t[0]) + __uint_as_float(t[1]);
}
template <int NP> __device__ __forceinline__ void load_rstd(const float* ssq, int row0, int fq, float inv_n, float (&rs)[2][4]) {
    float sv[8];
    if constexpr (NP == 32) {
#pragma unroll
        for (int h = 0; h < 2; ++h) { f32x4 a[4], b[4];
#pragma unroll
            for (int i = 0; i < 4; ++i) { const float* p = ssq + (size_t)(row0 + h * HALF + i * 16) * 32 + 8 * fq; a[i] = *(const f32x4*)p; b[i] = *(const f32x4*)(p + 4); }
#pragma unroll
            for (int i = 0; i < 4; ++i) sv[4 * h + i] = ((a[i][0] + a[i][1]) + (a[i][2] + a[i][3])) + ((b[i][0] + b[i][1]) + (b[i][2] + b[i][3]));
            asm volatile("" ::: "memory"); }
    } else { f32x2 a[8];
#pragma unroll
        for (int i = 0; i < 8; ++i) a[i] = *(const f32x2*)(ssq + (size_t)(row0 + (i >> 2) * HALF + (i & 3) * 16) * 8 + 2 * fq);
#pragma unroll
        for (int i = 0; i < 8; ++i) sv[i] = a[i][0] + a[i][1];
    }
#pragma unroll
    for (int i = 0; i < 8; ++i) sv[i] = xrow16_sum(sv[i]);
#pragma unroll
    for (int i = 0; i < 8; ++i) rs[i >> 2][i & 3] = __builtin_amdgcn_rsqf(sv[i] * inv_n + EPS);
}
template <int NP> __device__ __forceinline__ void load_rstd_cached(const float* ssq, int row0, int fq, int fr, float inv_n, float (&rs)[2][4], LAS float* rc, int pm) {
    const int tag = __builtin_amdgcn_readfirstlane(*(volatile LAS int*)(rc + 128));
    if (tag == pm) {
#pragma unroll
        for (int i = 0; i < 8; ++i) rs[i >> 2][i & 3] = rc[i * 16 + fr];
    } else {
        load_rstd<NP>(ssq, row0, fq, inv_n, rs);
        if (fq == 0) {
#pragma unroll
            for (int i = 0; i < 8; ++i) rc[i * 16 + fr] = rs[i >> 2][i & 3]; }
        *(volatile LAS int*)(rc + 128) = pm;
    }
}
struct EpiGateUp {
    static constexpr bool PERM = true; static constexpr int EREP = MK_EPI_REP;
    GAS unsigned char* ws;
    __device__ __forceinline__ void operator()(const f32x4 (&acc)[2][2][4][2], const Unit& u, int wr, int wc, int fr, int fq, LAS float* rc) const {
        bf16_t* O = (bf16_t*)(GAS bf16_t*)(ws + WS_BIG); const float* ssq = (const float*)(GAS float*)(ws + WS_SSQ);
        const int row0 = u.pm * BM + wr * 64 + fr, col0 = u.pn * HALF + wc * 32 + 8 * fq;
        float rs[2][4]; load_rstd_cached<32>(ssq, row0, fq, fr, 1.0f / DM, rs, rc, u.pm);
#pragma unroll
        for (int ai = 0; ai < 2; ++ai)
#pragma unroll
            for (int m = 0; m < 4; ++m) { const float r = rs[ai][m], c1 = -r * LOG2E, R = __builtin_amdgcn_rcpf(r * r); f32x2 t[4], gu[4];
#pragma unroll
                for (int i = 0; i < 4; ++i) { const f32x2 g = {acc[ai][0][m][i >> 1][2 * (i & 1)], acc[ai][0][m][i >> 1][2 * (i & 1) + 1]}, uu = {acc[ai][1][m][i >> 1][2 * (i & 1)], acc[ai][1][m][i >> 1][2 * (i & 1) + 1]};
                    t[i] = g * c1; gu[i] = g * uu; }
#pragma unroll
                for (int i = 0; i < 4; ++i) { t[i].x = __builtin_amdgcn_exp2f(t[i].x); t[i].y = __builtin_amdgcn_exp2f(t[i].y); }
#pragma unroll
                for (int i = 0; i < 4; ++i) { t[i].x = __builtin_fmaf(t[i].x, R, R); t[i].y = __builtin_fmaf(t[i].y, R, R); }
#pragma unroll
                for (int i = 0; i < 4; ++i) { t[i].x = __builtin_amdgcn_rcpf(t[i].x); t[i].y = __builtin_amdgcn_rcpf(t[i].y); }
#pragma unroll
                for (int i = 0; i < 4; ++i) gu[i] = gu[i] * t[i];
                u32x4 w; w.x = cvt_pk_bf16(gu[0].x, gu[0].y); w.y = cvt_pk_bf16(gu[1].x, gu[1].y); w.z = cvt_pk_bf16(gu[2].x, gu[2].y); w.w = cvt_pk_bf16(gu[3].x, gu[3].y);
                { const int row = row0 + ai * HALF + m * 16;
                  *(u32x4*)(O + ((size_t)((row >> 8) * (FF / 64) + (col0 >> 6)) * 256 + (row & 255)) * 64 + (col0 & 63)) = w; } }
    }
};
struct EpiResid {
    static constexpr bool PERM = true; static constexpr int EREP = 1;
    const bf16_t* base; bf16_t* outb; GAS unsigned char* ws; float scale;
    __device__ __forceinline__ void operator()(const f32x4 (&acc)[2][2][4][2], const Unit& u, int wr, int wc, int fr, int fq, LAS float* rc) const {
        float* ssq = (float*)(GAS float*)(ws + WS_SSQ);
        const int row0 = u.pm * BM + wr * 64 + fr, col0 = u.pn * BM + wc * 32 + 8 * fq;
#pragma unroll
        for (int hb = 0; hb < 2; ++hb) {
        u32x4 pre[4][2];
#pragma unroll
        for (int g4 = 0; g4 < 4; ++g4) { const size_t off = (size_t)(row0 + hb * HALF + g4 * 16) * DM + col0;
            pre[g4][0] = *(const u32x4*)(base + off); pre[g4][1] = *(const u32x4*)(base + off + HALF); }
#pragma unroll
        for (int g4 = 0; g4 < 4; ++g4) { const int ai = hb, m = g4, row = row0 + ai * HALF + m * 16; const size_t off = (size_t)row * DM + col0; float sq = 0.f;
            f32x2 sq2 = {0.f, 0.f};
#pragma unroll
            for (int bj = 0; bj < 2; ++bj) { const u32x4 b = pre[g4][bj];
                f32x2 x0 = {__uint_as_float(b.x << 16), __uint_as_float(b.x & 0xffff0000u)}, x1 = {__uint_as_float(b.y << 16), __uint_as_float(b.y & 0xffff0000u)};
                f32x2 x2 = {__uint_as_float(b.z << 16), __uint_as_float(b.z & 0xffff0000u)}, x3 = {__uint_as_float(b.w << 16), __uint_as_float(b.w & 0xffff0000u)};
                const f32x4 a0 = acc[ai][bj][m][0], a1 = acc[ai][bj][m][1];
                x0 = x0 + (f32x2){a0[0], a0[1]} * scale; x1 = x1 + (f32x2){a0[2], a0[3]} * scale; x2 = x2 + (f32x2){a1[0], a1[1]} * scale; x3 = x3 + (f32x2){a1[2], a1[3]} * scale;
                u32x4 w; w.x = cvt_pk_bf16(x0.x, x0.y); w.y = cvt_pk_bf16(x1.x, x1.y); w.z = cvt_pk_bf16(x2.x, x2.y); w.w = cvt_pk_bf16(x3.x, x3.y);
                *(u32x4*)(outb + off + bj * HALF) = w;
                sq2 = sq2 + x0 * x0; sq2 = sq2 + x1 * x1; sq2 = sq2 + x2 * x2; sq2 = sq2 + x3 * x3; }
            sq = sq2.x + sq2.y;
            sq = xrow16_sum(sq); if (fq == 0) ssq[(size_t)row * 32 + u.pn * 4 + wc] = sq; }
        asm volatile("" ::: "memory"); }
    }
};
struct EpiWin {
    static constexpr bool PERM = false; static constexpr int EREP = 1;
    GAS unsigned char* ws; const float* fbias;
    __device__ __forceinline__ void operator()(const f32x4 (&acc)[2][2][4][2], const Unit& u, int wr, int wc, int fr, int fq, LAS float* rc) const {
        bf16_t* P = (bf16_t*)(GAS bf16_t*)(ws + WS_P); bf16_t* KR = (bf16_t*)(GAS bf16_t*)(ws + WS_KR); float* logf = (float*)(GAS float*)(ws + WS_LOGF); const float* ssq = (const float*)(GAS float*)(ws + WS_SSQ);
        float* ssqq = (float*)(GAS float*)(ws + WS_SSQQ); float* ssqkv = (float*)(GAS float*)(ws + WS_SSQKV);
        const float* cosp = (const float*)(GAS float*)(ws + WS_COSP); const float* sinp = (const float*)(GAS float*)(ws + WS_SINP); const float* cosm = (const float*)(GAS float*)(ws + WS_COSM); const float* sinm = (const float*)(GAS float*)(ws + WS_SINM);
        const int row0 = u.pm * BM + wr * 64 + fr;
        float rs[2][4]; load_rstd_cached<32>(ssq, row0, fq, fr, 1.0f / DM, rs, rc, u.pm);
        const int pn = u.pn, grp = pn >> 1;
        if (pn < 16) {
            const float sc = (grp == 0) ? C2_FOX : (grp == 5) ? C2_DIL : 1.0f;
            const bool rope = (grp == 5 || grp == 6) && wc == 0;
            float* sq_dst = (grp == 3) ? ssqq : (grp == 4) ? ssqkv : nullptr;
#pragma unroll
            for (int ai = 0; ai < 2; ++ai)
#pragma unroll
                for (int m = 0; m < 4; ++m) { const int row = row0 + ai * HALF + m * 16; const float r = rs[ai][m]; const int s = row & (SEQ - 1); float sq = 0.f;
#pragma unroll
                    for (int bj = 0; bj < 2; ++bj) { f32x4 v0 = acc[ai][bj][m][0] * r, v1 = acc[ai][bj][m][1] * r;
                        sq += (v0[0] * v0[0] + v0[1] * v0[1]) + (v0[2] * v0[2] + v0[3] * v0[3]) + (v1[0] * v1[0] + v1[1] * v1[1]) + (v1[2] * v1[2] + v1[3] * v1[3]);
                        if (rope) { const f32x4 c = *(const f32x4*)(cosp + s * 16 + 4 * fq), sn = *(const f32x4*)(sinp + s * 16 + 4 * fq);
                            const f32x4 a = v0 * c - v1 * sn, b = v0 * sn + v1 * c; v0 = a; v1 = b; }
                        v0 = v0 * sc; v1 = v1 * sc;
                        bf16_t* p = P + (size_t)row * PP + pn * BM + bj * HALF + wc * 32 + 4 * fq;
                        u32x2 w0, w1; w0.x = cvt_pk_bf16(v0[0], v0[1]); w0.y = cvt_pk_bf16(v0[2], v0[3]); w1.x = cvt_pk_bf16(v1[0], v1[1]); w1.y = cvt_pk_bf16(v1[2], v1[3]);
                        *(u32x2*)p = w0; *(u32x2*)(p + 16) = w1; }
                    if (sq_dst) { sq = xrow16_sum(sq); if (fq == 0) sq_dst[(size_t)row * 8 + (pn & 1) * 4 + wc] = sq; } }
        } else {
            if (wc < 2) {
#pragma unroll
                for (int ai = 0; ai < 2; ++ai)
#pragma unroll
                    for (int m = 0; m < 4; ++m) { const int row = row0 + ai * HALF + m * 16; const float r = rs[ai][m]; const int s = row & (SEQ - 1); const int d = 16 * wc + 4 * fq;
                        const f32x4 x1 = acc[ai][0][m][0] * r, x2 = acc[ai][0][m][1] * r;
                        const f32x4 c = *(const f32x4*)(cosm + s * 32 + d), sn = *(const f32x4*)(sinm + s * 32 + d);
                        const f32x4 a = x1 * c - x2 * sn, b = x1 * sn + x2 * c;
                        u32x2 w0, w1; w0.x = cvt_pk_bf16(a[0], a[1]); w0.y = cvt_pk_bf16(a[2], a[3]); w1.x = cvt_pk_bf16(b[0], b[1]); w1.y = cvt_pk_bf16(b[2], b[3]);
                        *(u32x2*)(KR + (size_t)row * 64 + d) = w0; *(u32x2*)(KR + (size_t)row * 64 + d + 32) = w1; }
            } else if (wc == 2 && fq == 0) {
                const f32x4 fb = *(const f32x4*)fbias;
#pragma unroll
                for (int ai = 0; ai < 2; ++ai)
#pragma unroll
                    for (int m = 0; m < 4; ++m) { const int row = row0 + ai * HALF + m * 16; const f32x4 z = acc[ai][0][m][0] * rs[ai][m] + fb; f32x4 o;
#pragma unroll
                        for (int j = 0; j < 4; ++j) { const float az = fabsf(z[j]); o[j] = fminf(z[j], 0.f) - log1pf(__expf(-az)); }
                        *(f32x4*)(logf + (size_t)row * 4) = o; }
            }
        }
    }
};
struct EpiUq {
    static constexpr bool PERM = false; static constexpr int EREP = 1;
    GAS unsigned char* ws;
    __device__ __forceinline__ void operator()(const f32x4 (&acc)[2][2][4][2], const Unit& u, int wr, int wc, int fr, int fq, LAS float* rc) const {
        bf16_t* QBn = (bf16_t*)(GAS bf16_t*)(ws + WS_QBN); bf16_t* QBr = (bf16_t*)(GAS bf16_t*)(ws + WS_QBR); const float* ssqq = (const float*)(GAS float*)(ws + WS_SSQQ);
        const float* cosm = (const float*)(GAS float*)(ws + WS_COSM); const float* sinm = (const float*)(GAS float*)(ws + WS_SINM);
        const int row0 = u.pm * BM + wr * 64 + fr;
        float rs[2][4]; load_rstd<8>(ssqq, row0, fq, 1.0f / 512, rs);
        const int pn = u.pn;
#pragma unroll
        for (int ai = 0; ai < 2; ++ai)
#pragma unroll
            for (int m = 0; m < 4; ++m) { const int row = row0 + ai * HALF + m * 16; const float r = rs[ai][m] * C2_MLA; const int s = row & (SEQ - 1);
#pragma unroll
                for (int bj = 0; bj < 2; ++bj) { const f32x4 v0 = acc[ai][bj][m][0] * r, v1 = acc[ai][bj][m][1] * r;
                    if (pn < 4) { bf16_t* p = QBn + (size_t)row * 1024 + pn * BM + bj * HALF + wc * 32 + 4 * fq;
                        u32x2 w0, w1; w0.x = cvt_pk_bf16(v0[0], v0[1]); w0.y = cvt_pk_bf16(v0[2], v0[3]); w1.x = cvt_pk_bf16(v1[0], v1[1]); w1.y = cvt_pk_bf16(v1[2], v1[3]);
                        *(u32x2*)p = w0; *(u32x2*)(p + 16) = w1; }
                    else { const int head = (pn - 4) * 4 + 2 * bj + (wc >> 1), d = 16 * (wc & 1) + 4 * fq;
                        const f32x4 c = *(const f32x4*)(cosm + s * 32 + d), sn = *(const f32x4*)(sinm + s * 32 + d);
                        const f32x4 a = v0 * c - v1 * sn, b = v0 * sn + v1 * c;
                        u32x2 w0, w1; w0.x = cvt_pk_bf16(a[0], a[1]); w0.y = cvt_pk_bf16(a[2], a[3]); w1.x = cvt_pk_bf16(b[0], b[1]); w1.y = cvt_pk_bf16(b[2], b[3]);
                        bf16_t* p = QBr + (size_t)row * 512 + head * 64 + d; *(u32x2*)p = w0; *(u32x2*)(p + 32) = w1; } } }
    }
};
struct EpiUkv {
    static constexpr bool PERM = true; static constexpr int EREP = 1;
    GAS unsigned char* ws;
    __device__ __forceinline__ void operator()(const f32x4 (&acc)[2][2][4][2], const Unit& u, int wr, int wc, int fr, int fq, LAS float* rc) const {
        bf16_t* KVB = (bf16_t*)(GAS bf16_t*)(ws + WS_KVB); const float* ssqkv = (const float*)(GAS float*)(ws + WS_SSQKV);
        const int row0 = u.pm * BM + wr * 64 + fr, col0 = u.pn * BM + wc * 32 + 8 * fq;
        float rs[2][4]; load_rstd<8>(ssqkv, row0, fq, 1.0f / 512, rs);
#pragma unroll
        for (int ai = 0; ai < 2; ++ai)
#pragma unroll
            for (int m = 0; m < 4; ++m) { const float r = rs[ai][m]; bf16_t* rowp = KVB + (size_t)(row0 + ai * HALF + m * 16) * 2048 + col0;
#pragma unroll
                for (int bj = 0; bj < 2; ++bj) { const f32x4 v0 = acc[ai][bj][m][0] * r, v1 = acc[ai][bj][m][1] * r;
                    u32x4 w; w.x = cvt_pk_bf16(v0[0], v0[1]); w.y = cvt_pk_bf16(v0[2], v0[3]); w.z = cvt_pk_bf16(v1[0], v1[1]); w.w = cvt_pk_bf16(v1[2], v1[3]);
                    *(u32x4*)(rowp + bj * HALF) = w; } }
    }
};
}

namespace att {
#define SBAR() __builtin_amdgcn_sched_barrier(0)
constexpr int SHM = 16384, SHMR = 8192;
constexpr int SHMV = SHM;
constexpr int OFF_V = 0, OFF_K = 3 * SHMV, OFF_KR = OFF_K + 3 * SHM, OFF_CUM = OFF_KR, ATT_LDS = OFF_KR + 3 * SHMR, OFF_WS = 131072 + 8192;
constexpr float THR2 = 24.0f;
static_assert(ATT_LDS <= 131072, "attention LDS");
__device__ __forceinline__ int kswz(int row, int colB) { return row * 256 + (colB ^ ((row & 15) << 4)); }
__device__ __forceinline__ int krswz(int row, int chunk) { return row * 128 + ((chunk ^ ((row >> 1) & 7)) << 4); }
typedef short v4i16_t __attribute__((ext_vector_type(4)));
__device__ __forceinline__ s16x4 vtr(const LAS unsigned char* p) { return __builtin_bit_cast(s16x4, __builtin_amdgcn_ds_read_tr16_b64_v4i16((LAS v4i16_t*)p)); }
__device__ __forceinline__ float xrow16_max(float x) {
    auto s = __builtin_amdgcn_permlane16_swap(__float_as_uint(x), __float_as_uint(x), false, false);
    x = fmaxf(__uint_as_float(s[0]), __uint_as_float(s[1]));
    auto t = __builtin_amdgcn_permlane32_swap(__float_as_uint(x), __float_as_uint(x), false, false);
    return fmaxf(__uint_as_float(t[0]), __uint_as_float(t[1]));
}
template <int OFF> __device__ __forceinline__ s16x4 vtra(unsigned a) { s16x4 r; asm volatile("ds_read_b64_tr_b16 %0, %1 offset:%2" : "=v"(r) : "v"(a), "n"(OFF) : "memory"); return r; }
__device__ __forceinline__ f32x4 mf16(bf16x8 a, bf16x8 b, f32x4 c) { return __builtin_amdgcn_mfma_f32_16x16x32_bf16(a, b, c, 0, 0, 0); }

struct Blk {
    const bf16_t* Q; long qs;
    const bf16_t* Qr; long qrs;
    const bf16_t* K; long ks;
    const bf16_t* Kr; long krs;
    const bf16_t* V; long vs;
    bf16_t* O; long os;
    float* Lo; long ls;
    const bf16_t* O2; const bf16_t* O3; const float* L2; const float* L3; long o23s; long l23s;
    int P0; int W;
};
template <int MODE>
__device__ __forceinline__ void attn_block(const Blk& B, LAS unsigned char* lds) {
    int tid_o = threadIdx.x; asm volatile("" : "+v"(tid_o));
    const int tid = tid_o, wid = __builtin_amdgcn_readfirstlane(tid >> 6), lane = tid & 63, fr = lane & 15, fq = lane >> 4;
    LAS unsigned char* V_lds = lds + OFF_V; LAS unsigned char* K_lds = lds + OFF_K; LAS unsigned char* KR_lds = lds + OFF_KR;
    const LAS float* biasL = (const LAS float*)(lds + OFF_CUM);
    bf16x8 qf[2][4]; bf16x8 qrf[2][2];
#pragma unroll
    for (int c = 0; c < 2; ++c) { const bf16_t* qp = B.Q + (long)(wid * 32 + 16 * c + fr) * B.qs + fq * 8;
#pragma unroll
        for (int s_ = 0; s_ < 4; ++s_) qf[c][s_] = *(const bf16x8*)(qp + 32 * s_);
        if constexpr (MODE == 1) { const bf16_t* qp2 = B.Qr + (long)(wid * 32 + 16 * c + fr) * B.qrs + fq * 8;
#pragma unroll
            for (int s_ = 0; s_ < 2; ++s_) qrf[c][s_] = *(const bf16x8*)(qp2 + 32 * s_); } }
    const int W = B.W, P0 = B.P0;
    const int lowk = P0 - W + 1; const int j_lo = lowk > 0 ? lowk / 64 : 0; const int j_hi = (P0 + 255) / 64 + 1;
    const int qpos0 = P0 + wid * 32 + fr;
    float m0 = -1e30f, m1 = -1e30f, l0 = 0.f, l1 = 0.f;
    f32x4 oacc[8][2];
#pragma unroll
    for (int d = 0; d < 8; ++d) { oacc[d][0] = f32x4{0.f, 0.f, 0.f, 0.f}; oacc[d][1] = f32x4{0.f, 0.f, 0.f, 0.f}; }
    const int dr = 8 * wid + (lane >> 4);
    const int kof0 = ((lane & 15) ^ (dr & 15)) * 8, kof1 = ((lane & 15) ^ ((dr + 4) & 15)) * 8;
    const int vof0 = ((((lane & 15) >> 1) ^ (dr & 7)) * 16) + (lane & 1) * 8, vof1 = ((((lane & 15) >> 1) ^ ((dr + 4) & 7)) * 16) + (lane & 1) * 8;
    const int rr = 8 * wid + (lane >> 3); const int rof = ((lane & 7) ^ ((rr >> 1) & 7)) * 8;
    constexpr int NDMA = (MODE == 1) ? 5 : 4;
    const __amdgpu_buffer_rsrc_t srK = __builtin_amdgcn_make_buffer_rsrc((void*)B.K, (short)0, 0x7fffffff, 0x00020000), srV = __builtin_amdgcn_make_buffer_rsrc((void*)B.V, (short)0, 0x7fffffff, 0x00020000);
    const __amdgpu_buffer_rsrc_t srR = __builtin_amdgcn_make_buffer_rsrc((void*)(MODE == 1 ? B.Kr : B.K), (short)0, 0x7fffffff, 0x00020000);
    const int ko0 = (int)((dr * B.ks + kof0) * 2), ko1 = (int)(((dr + 4) * B.ks + kof1) * 2), vo0 = (int)((dr * B.vs + vof0) * 2), vo1 = (int)(((dr + 4) * B.vs + vof1) * 2), ro0 = (int)((rr * B.krs + rof) * 2);
    const int kts = (int)(B.ks * 128), vts = (int)(B.vs * 128), rts = (int)(B.krs * 128);
#define T_DMA_K(t_, b_) do { const int so_ = (t_) * kts; \
        __builtin_amdgcn_raw_ptr_buffer_load_lds(srK, (LAS void*)(K_lds + (b_) * SHM + wid * 2048), 16, ko0, so_, 0, 0); \
        __builtin_amdgcn_raw_ptr_buffer_load_lds(srK, (LAS void*)(K_lds + (b_) * SHM + wid * 2048 + 1024), 16, ko1, so_, 0, 0); } while (0)
#define T_DMA_V(t_, b_) do { const int so_ = (t_) * vts; \
        __builtin_amdgcn_raw_ptr_buffer_load_lds(srV, (LAS void*)(V_lds + (b_) * SHMV + wid * 2048), 16, vo0, so_, 0, 0); \
        __builtin_amdgcn_raw_ptr_buffer_load_lds(srV, (LAS void*)(V_lds + (b_) * SHMV + wid * 2048 + 1024), 16, vo1, so_, 0, 0); } while (0)
#define T_DMA_R(t_, b_) do { if constexpr (MODE == 1) __builtin_amdgcn_raw_ptr_buffer_load_lds(srR, (LAS void*)(KR_lds + (b_) * SHMR + wid * 1024), 16, ro0, (t_) * rts, 0, 0); } while (0)
#define T_DMA(t_, b_) do { T_DMA_K(t_, b_); T_DMA_V(t_, b_); T_DMA_R(t_, b_); } while (0)
#define T_LANDED() do { if constexpr (MODE == 1) asm volatile("s_waitcnt vmcnt(5)" ::: "memory"); else asm volatile("s_waitcnt vmcnt(4)" ::: "memory"); } while (0)
    int vpb[8];
#pragma unroll
    for (int d = 0; d < 8; ++d) vpb[d] = (4 * fq + (fr >> 2)) * 256 + ((d ^ (4 * (fq & 1) + (fr >> 2))) * 32) + (fr & 3) * 8;
#define PK8(S0_, S1_, OUT) do { u32x4 w_ = {cvt_pk_bf16(S0_[0], S0_[1]), cvt_pk_bf16(S0_[2], S0_[3]), cvt_pk_bf16(S1_[0], S1_[1]), cvt_pk_bf16(S1_[2], S1_[3])}; OUT = __builtin_bit_cast(bf16x8, w_); } while (0)
#define VLD(L_, H_, d0) do { const unsigned a0_ = vp_ + (unsigned)vpb[2 * (d0)], a1_ = vp_ + (unsigned)vpb[2 * (d0) + 1]; \
        L_[0] = vtra<0>(a0_); H_[0] = vtra<4096>(a0_); L_[1] = vtra<8192>(a0_); H_[1] = vtra<12288>(a0_); L_[2] = vtra<0>(a1_); H_[2] = vtra<4096>(a1_); L_[3] = vtra<8192>(a1_); H_[3] = vtra<12288>(a1_); } while (0)
#define LWAIT8(L_, H_) asm volatile("s_waitcnt lgkmcnt(0)" : "+v"(L_[0]), "+v"(L_[1]), "+v"(L_[2]), "+v"(L_[3]), "+v"(H_[0]), "+v"(H_[1]), "+v"(H_[2]), "+v"(H_[3]) :: "memory")
#define VFR(L_, H_, k_) (bf16x8){L_[k_][0], L_[k_][1], L_[k_][2], L_[k_][3], H_[k_][0], H_[k_][1], H_[k_][2], H_[k_][3]}
#define VMF(L_, H_, d0) do { oacc[2 * (d0)][0] = mf16(VFR(L_, H_, 0), pb00, oacc[2 * (d0)][0]); oacc[2 * (d0)][1] = mf16(VFR(L_, H_, 0), pb01, oacc[2 * (d0)][1]); \
        oacc[2 * (d0) + 1][0] = mf16(VFR(L_, H_, 2), pb00, oacc[2 * (d0) + 1][0]); oacc[2 * (d0) + 1][1] = mf16(VFR(L_, H_, 2), pb01, oacc[2 * (d0) + 1][1]); \
        oacc[2 * (d0)][0] = mf16(VFR(L_, H_, 1), pb10, oacc[2 * (d0)][0]); oacc[2 * (d0)][1] = mf16(VFR(L_, H_, 1), pb11, oacc[2 * (d0)][1]); \
        oacc[2 * (d0) + 1][0] = mf16(VFR(L_, H_, 3), pb10, oacc[2 * (d0) + 1][0]); oacc[2 * (d0) + 1][1] = mf16(VFR(L_, H_, 3), pb11, oacc[2 * (d0) + 1][1]); } while (0)
#define PV_ALL(buf_, DMA_) do { const unsigned vp_ = (unsigned)(size_t)(V_lds + (buf_) * SHMV); s16x4 la_[4], ha_[4], lb_[4], hb_[4]; \
        SBAR(); VLD(la_, ha_, 0); VLD(lb_, hb_, 1); LWAIT8(la_, ha_); LWAIT8(lb_, hb_); SBAR(); \
        VMF(la_, ha_, 0); VLD(la_, ha_, 2); DMA_; SBAR(); \
        VMF(lb_, hb_, 1); VLD(lb_, hb_, 3); LWAIT8(la_, ha_); LWAIT8(lb_, hb_); SBAR(); \
        VMF(la_, ha_, 2); SBAR(); VMF(lb_, hb_, 3); SBAR(); } while (0)
#define KLD(F_, Kb_, s_) do { const LAS unsigned char* a_ = (Kb_) + kswz(fr, (32 * (s_) + 8 * fq) * 2); \
        F_[0] = *(const LAS bf16x8*)a_; F_[1] = *(const LAS bf16x8*)(a_ + 4096); F_[2] = *(const LAS bf16x8*)(a_ + 8192); F_[3] = *(const LAS bf16x8*)(a_ + 12288); } while (0)
#define KMF(F_, s_) do { sa0[0] = mf16(F_[0], qf[0][s_], sa0[0]); sa0[1] = mf16(F_[0], qf[1][s_], sa0[1]); sa1[0] = mf16(F_[1], qf[0][s_], sa1[0]); sa1[1] = mf16(F_[1], qf[1][s_], sa1[1]); \
        sa2[0] = mf16(F_[2], qf[0][s_], sa2[0]); sa2[1] = mf16(F_[2], qf[1][s_], sa2[1]); sa3[0] = mf16(F_[3], qf[0][s_], sa3[0]); sa3[1] = mf16(F_[3], qf[1][s_], sa3[1]); } while (0)
#define KRLD(F_, Kb_, s_) do { const LAS unsigned char* a_ = (Kb_) + krswz(fr, 4 * (s_) + fq); \
        F_[0] = *(const LAS bf16x8*)a_; F_[1] = *(const LAS bf16x8*)(a_ + 2048); F_[2] = *(const LAS bf16x8*)(a_ + 4096); F_[3] = *(const LAS bf16x8*)(a_ + 6144); } while (0)
#define KRMF(F_, s_) do { sa0[0] = mf16(F_[0], qrf[0][s_], sa0[0]); sa0[1] = mf16(F_[0], qrf[1][s_], sa0[1]); sa1[0] = mf16(F_[1], qrf[0][s_], sa1[0]); sa1[1] = mf16(F_[1], qrf[1][s_], sa1[1]); \
        sa2[0] = mf16(F_[2], qrf[0][s_], sa2[0]); sa2[1] = mf16(F_[2], qrf[1][s_], sa2[1]); sa3[0] = mf16(F_[3], qrf[0][s_], sa3[0]); sa3[1] = mf16(F_[3], qrf[1][s_], sa3[1]); } while (0)
    const int NT = j_hi - j_lo;
    const int qlo = P0 + wid * 32;
    bf16x8 pb00 = {}, pb01 = {}, pb10 = {}, pb11 = {};
    T_DMA(j_lo, 0);
    asm volatile("s_waitcnt vmcnt(0)" ::: "memory");
    __syncthreads();
    T_DMA((j_lo + 1 < j_hi) ? j_lo + 1 : j_hi - 1, 1);
    int cur = 0;
    for (int i = 0; i < NT; ++i) {
        const int t = j_lo + i, kb = t * 64;
        const int nxt = (cur == 2) ? 0 : cur + 1, nx2 = (cur == 0) ? 2 : cur - 1;
        const int t_ld = (t + 2 < j_hi) ? t + 2 : j_hi - 1;
        const bool need = (kb <= qlo + 31) && (kb + 63 > qlo - W);
        if (need) {
        f32x4 sa0[2], sa1[2], sa2[2], sa3[2];
#pragma unroll
        for (int c = 0; c < 2; ++c) { sa0[c] = f32x4{0.f, 0.f, 0.f, 0.f}; sa1[c] = f32x4{0.f, 0.f, 0.f, 0.f}; sa2[c] = f32x4{0.f, 0.f, 0.f, 0.f}; sa3[c] = f32x4{0.f, 0.f, 0.f, 0.f}; }
        { const LAS unsigned char* Kb = K_lds + cur * SHM; bf16x8 ka_[4], kb_[4];
          SBAR(); KLD(ka_, Kb, 0); KLD(kb_, Kb, 1); SBAR();
          KMF(ka_, 0); KLD(ka_, Kb, 2); SBAR();
          KMF(kb_, 1); KLD(kb_, Kb, 3); SBAR();
          if constexpr (MODE == 1) { const LAS unsigned char* Krb = KR_lds + cur * SHMR;
              KMF(ka_, 2); KRLD(ka_, Krb, 0); SBAR();
              KMF(kb_, 3); KRLD(kb_, Krb, 1); T_DMA_K(t_ld, nx2); SBAR();
              KRMF(ka_, 0); T_DMA_R(t_ld, nx2); SBAR(); KRMF(kb_, 1); SBAR();
          } else { KMF(ka_, 2); T_DMA_K(t_ld, nx2); SBAR(); KMF(kb_, 3); SBAR(); } }
        if constexpr (MODE == 0) {
            const f32x4 b0 = *(const LAS f32x4*)(biasL + kb + 4 * fq), b1 = *(const LAS f32x4*)(biasL + kb + 16 + 4 * fq), b2 = *(const LAS f32x4*)(biasL + kb + 32 + 4 * fq), b3 = *(const LAS f32x4*)(biasL + kb + 48 + 4 * fq);
#pragma unroll
            for (int c = 0; c < 2; ++c) { sa0[c] += b0; sa1[c] += b1; sa2[c] += b2; sa3[c] += b3; } }
        if (kb + 63 > qlo || kb <= qlo + 31 - W) { const int dq = qpos0 - kb - 4 * fq; const float NEG = -__builtin_inff();
#pragma unroll
          for (int c = 0; c < 2; ++c)
#pragma unroll
            for (int ii = 0; ii < 4; ++ii) { const int e = dq + 16 * c - ii;
              if ((unsigned)(e) >= (unsigned)W) sa0[c][ii] = NEG;
              if ((unsigned)(e - 16) >= (unsigned)W) sa1[c][ii] = NEG;
              if ((unsigned)(e - 32) >= (unsigned)W) sa2[c][ii] = NEG;
              if ((unsigned)(e - 48) >= (unsigned)W) sa3[c][ii] = NEG; } }
        float pm0, pm1;
        { f32x4 x0 = sa0[0], x1 = sa0[1];
#pragma unroll
          for (int ii = 0; ii < 4; ++ii) { x0[ii] = fmaxf(fmaxf(x0[ii], sa1[0][ii]), fmaxf(sa2[0][ii], sa3[0][ii])); x1[ii] = fmaxf(fmaxf(x1[ii], sa1[1][ii]), fmaxf(sa2[1][ii], sa3[1][ii])); }
          pm0 = fmaxf(fmaxf(x0[0], x0[1]), fmaxf(x0[2], x0[3])); pm1 = fmaxf(fmaxf(x1[0], x1[1]), fmaxf(x1[2], x1[3])); }
        float mn0, mn1, al0, al1;
        if (__builtin_expect(__all(fmaxf(pm0 - m0, pm1 - m1) <= THR2), 1)) { mn0 = m0; mn1 = m1; al0 = 1.f; al1 = 1.f; }
        else { pm0 = xrow16_max(pm0); pm1 = xrow16_max(pm1); mn0 = fmaxf(m0, pm0); al0 = __builtin_amdgcn_exp2f(m0 - mn0); m0 = mn0; mn1 = fmaxf(m1, pm1); al1 = __builtin_amdgcn_exp2f(m1 - mn1); m1 = mn1; }
#pragma unroll
        for (int ii = 0; ii < 4; ++ii) {
            sa0[0][ii] = __builtin_amdgcn_exp2f(sa0[0][ii] - mn0); sa1[0][ii] = __builtin_amdgcn_exp2f(sa1[0][ii] - mn0); sa2[0][ii] = __builtin_amdgcn_exp2f(sa2[0][ii] - mn0); sa3[0][ii] = __builtin_amdgcn_exp2f(sa3[0][ii] - mn0);
            sa0[1][ii] = __builtin_amdgcn_exp2f(sa0[1][ii] - mn1); sa1[1][ii] = __builtin_amdgcn_exp2f(sa1[1][ii] - mn1); sa2[1][ii] = __builtin_amdgcn_exp2f(sa2[1][ii] - mn1); sa3[1][ii] = __builtin_amdgcn_exp2f(sa3[1][ii] - mn1); }
        { f32x4 y0 = (sa0[0] + sa1[0]) + (sa2[0] + sa3[0]), y1 = (sa0[1] + sa1[1]) + (sa2[1] + sa3[1]);
          l0 = l0 * al0 + ((y0[0] + y0[1]) + (y0[2] + y0[3])); l1 = l1 * al1 + ((y1[0] + y1[1]) + (y1[2] + y1[3])); }
        PK8(sa0[0], sa1[0], pb00); PK8(sa0[1], sa1[1], pb01); PK8(sa2[0], sa3[0], pb10); PK8(sa2[1], sa3[1], pb11);
        if (__any(al0 < 1.f || al1 < 1.f)) {
#pragma unroll
            for (int d = 0; d < 8; ++d) { oacc[d][0] *= al0; oacc[d][1] *= al1; } }
        PV_ALL(cur, T_DMA_V(t_ld, nx2));
        } else T_DMA(t_ld, nx2);
        T_LANDED();
        __syncthreads();
        cur = nxt;
    }
    asm volatile("s_waitcnt vmcnt(0)" ::: "memory");
#undef PV_ALL
#undef VMF
#undef VFR
#undef VLD
#undef LWAIT8
#undef KLD
#undef KMF
#undef KRLD
#undef KRMF
#undef PK8
#undef T_DMA
#undef T_DMA_K
#undef T_DMA_V
#undef T_DMA_R
#undef T_LANDED
    l0 = pg8::xrow16_sum(l0); l1 = pg8::xrow16_sum(l1);
    float lsum[2] = {l0, l1}, mrow[2] = {m0, m1};
#pragma unroll
    for (int c = 0; c < 2; ++c) {
        const long qi = wid * 32 + 16 * c + fr;
        const float lse2 = mrow[c] + __builtin_amdgcn_logf(lsum[c]);
        float wgt = __builtin_amdgcn_rcpf(lsum[c]); float w2 = 0.f, w3 = 0.f;
        if constexpr (MODE == 2) { if (fq == 0) B.Lo[qi * B.ls] = lse2; }
        if constexpr (MODE == 3) { const float a2 = B.L2[qi * B.l23s], a3 = B.L3[qi * B.l23s];
            const float mx = fmaxf(lse2, fmaxf(a2, a3)); const float e1 = __builtin_amdgcn_exp2f(lse2 - mx), e2 = __builtin_amdgcn_exp2f(a2 - mx), e3 = __builtin_amdgcn_exp2f(a3 - mx);
            const float inv = __builtin_amdgcn_rcpf(e1 + e2 + e3); wgt = e1 * inv * wgt; w2 = e2 * inv; w3 = e3 * inv; }
        bf16_t* Ow = B.O + qi * B.os + 4 * fq;
#pragma unroll
        for (int d = 0; d < 8; ++d) { f32x4 v = oacc[d][c] * wgt;
            if constexpr (MODE == 3) { const long po = qi * B.o23s + 16 * d + 4 * fq; const u32x2 u2 = *(const u32x2*)(B.O2 + po), u3 = *(const u32x2*)(B.O3 + po);
                v[0] += w2 * __uint_as_float(u2.x << 16) + w3 * __uint_as_float(u3.x << 16); v[1] += w2 * __uint_as_float(u2.x & 0xffff0000u) + w3 * __uint_as_float(u3.x & 0xffff0000u);
                v[2] += w2 * __uint_as_float(u2.y << 16) + w3 * __uint_as_float(u3.y << 16); v[3] += w2 * __uint_as_float(u2.y & 0xffff0000u) + w3 * __uint_as_float(u3.y & 0xffff0000u); }
            u32x2 w; w.x = cvt_pk_bf16(v[0], v[1]); w.y = cvt_pk_bf16(v[2], v[3]); *(u32x2*)(Ow + 16 * d) = w; } }
    __syncthreads();
}
__device__ __forceinline__ void fox_bias_table(const float* logf, int b, int h, LAS unsigned char* lds) {
    int tid_o = threadIdx.x; asm volatile("" : "+v"(tid_o));
    const int tid = tid_o, wid = tid >> 6, lane = tid & 63;
    LAS float* biasL = (LAS float*)(lds + OFF_CUM); LAS float* wsum = (LAS float*)(lds + OFF_WS);
    float v[8]; float run = 0.f;
#pragma unroll
    for (int i = 0; i < 8; ++i) { run += logf[((size_t)b * SEQ + 8 * tid + i) * 4 + h]; v[i] = run; }
    float sc = run;
#pragma unroll
    for (int o = 1; o < 64; o <<= 1) { const float n = __shfl_up(sc, o); if (lane >= o) sc += n; }
    const float excl = sc - run;
    __syncthreads();
    if (lane == 63) wsum[wid] = sc;
    __syncthreads();
    float wpre = 0.f;
    for (int w = 0; w < wid; ++w) wpre += wsum[w];
#pragma unroll
    for (int i = 0; i < 8; ++i) biasL[8 * tid + i] = -(v[i] + excl + wpre) * LOG2E;
    __syncthreads();
}
#undef SBAR
}

#define XB_TMO      128
#define XB_XCNT(j)  (256  + 64 * (j))
#define XB_XSUB(j)  (1280 + 64 * (j))
#define XB_XGEN(j)  (2304 + 64 * (j))
#define XB_TOP      3328
#define XB_TOPGEN   3392
#define XCD_BAR_WORDS 3456
#define XB_SPIN_CAP (1u << 18)
__device__ __forceinline__ unsigned xb_ld(unsigned* p)              { return __hip_atomic_load(p, __ATOMIC_RELAXED, __HIP_MEMORY_SCOPE_AGENT); }
__device__ __forceinline__ unsigned xb_add(unsigned* p, unsigned v) { return __hip_atomic_fetch_add(p, v, __ATOMIC_RELAXED, __HIP_MEMORY_SCOPE_AGENT); }
__device__ __forceinline__ unsigned xb_xcc_id() { return (unsigned)__builtin_amdgcn_s_getreg((3 << 11) | 20) & 0xFu; }
#define XB_SPIN(cond, bar) do { unsigned _sp = 0; while (cond) { __builtin_amdgcn_s_sleep(1); \
    if ((++_sp & 255u) == 0u) { if (xb_ld(&(bar)[XB_TMO])) break; if (_sp > XB_SPIN_CAP) { atomicAdd(&(bar)[XB_TMO], 1u); break; } } } } while (0)
struct XcdBarrier { unsigned* bar; unsigned x; volatile LAS unsigned* st; };
__device__ __forceinline__ XcdBarrier xcd_barrier_post(unsigned* bar, volatile LAS unsigned* st) {
    XcdBarrier b; b.bar = bar; b.x = xb_xcc_id(); b.st = st;
    if (threadIdx.x == 0) (void)xb_add(&bar[XB_XCNT(b.x)], 1u);
    return b;
}
__device__ __forceinline__ void xcd_barrier_complete(unsigned* bar, unsigned x, unsigned& nloc, unsigned& nx) {
    const unsigned G = gridDim.x * gridDim.y * gridDim.z;
    unsigned sum, cnt, mine, sp = 0u;
    for (;;) {
        sum = 0u; cnt = 0u; mine = 0u;
#pragma unroll
        for (unsigned j = 0; j < 16; ++j) { const unsigned c = xb_ld(&bar[XB_XCNT(j)]); sum += c; cnt += (c > 0u) ? 1u : 0u; mine = (j == x) ? c : mine; }
        if (sum == G) break;
        __builtin_amdgcn_s_sleep(1);
        if ((++sp & 255u) == 0u) { if (xb_ld(&bar[XB_TMO])) break; if (sp > XB_SPIN_CAP) { atomicAdd(&bar[XB_TMO], 1u); break; } }
    }
    nloc = mine > 0u ? mine : 1u; nx = cnt > 0u ? cnt : 1u;
}
__device__ __forceinline__ void xcd_barrier(const XcdBarrier& b) {
    asm volatile("s_waitcnt vmcnt(0)" ::: "memory");
    __syncthreads();
    if (threadIdx.x == 0) {
        unsigned* bar = b.bar;
        __builtin_amdgcn_s_waitcnt(0);
        unsigned nloc = b.st[0], nx = b.st[1];
        if (nloc == 0u) { xcd_barrier_complete(bar, b.x, nloc, nx); b.st[0] = nloc; b.st[1] = nx; }
        const unsigned old = xb_add(&bar[XB_XSUB(b.x)], 1u);
        const unsigned gen = old / nloc;
        if (old + 1u == (gen + 1u) * nloc) {
            __builtin_amdgcn_fence(__ATOMIC_RELEASE, "agent");
            asm volatile("s_waitcnt vmcnt(0)" ::: "memory");
            const unsigned og = xb_add(&bar[XB_TOP], 1u);
            const unsigned tg = og / nx;
            if (og + 1u == (tg + 1u) * nx) xb_add(&bar[XB_TOPGEN], 1u);
            else XB_SPIN(xb_ld(&bar[XB_TOPGEN]) == tg, bar);
            __builtin_amdgcn_fence(__ATOMIC_ACQUIRE, "agent");
            xb_add(&bar[XB_XGEN(b.x)], 1u);
            asm volatile("s_waitcnt vmcnt(0)" ::: "memory");
        } else {
            XB_SPIN(xb_ld(&bar[XB_XGEN(b.x)]) == gen, bar);
            __builtin_amdgcn_fence(__ATOMIC_ACQUIRE, "agent");
            asm volatile("s_waitcnt vmcnt(0)" ::: "memory");
        }
    }
    __syncthreads();
}

__device__ __forceinline__ unsigned f2bf(float f) { unsigned u = __builtin_bit_cast(unsigned, f); return (u + 0x7fffu + ((u >> 16) & 1u)) >> 16; }
__device__ __forceinline__ unsigned pk2(float lo, float hi) { return f2bf(lo) | (f2bf(hi) << 16); }
__device__ __forceinline__ void cvt_item(const float* W, int ldw, const float* gain, bf16_t* WT, int K, int n0, int k0, int src4, LAS float* scr, int lane) {
    const int kq = lane >> 3, c4 = lane & 7;
    f32x4 v[8]; float g[8];
#pragma unroll
    for (int i = 0; i < 8; ++i) { v[i] = (src4 >= 0) ? *(const f32x4*)(W + (size_t)(k0 + 8 * i + kq) * ldw + src4) : (f32x4){0.f, 0.f, 0.f, 0.f}; g[i] = gain ? gain[k0 + 8 * i + kq] : 1.0f; }
#pragma unroll
    for (int i = 0; i < 8; ++i) { LAS float* d = scr + (8 * i + kq) * 33 + 4 * c4; const f32x4 w = v[i] * g[i]; d[0] = w[0]; d[1] = w[1]; d[2] = w[2]; d[3] = w[3]; }
    LDS_WAIT(); asm volatile("" ::: "memory");
    const int c = lane & 7;
#pragma unroll
    for (int j = 0; j < 4; ++j) { const int n = (lane >> 3) + 8 * j; const LAS float* s = scr + (8 * c) * 33 + n;
        u32x4 o; o.x = pk2(s[0 * 33], s[1 * 33]); o.y = pk2(s[2 * 33], s[3 * 33]); o.z = pk2(s[4 * 33], s[5 * 33]); o.w = pk2(s[6 * 33], s[7 * 33]);
        *(u32x4*)(WT + (size_t)(n0 + n) * K + k0 + 8 * c) = o; }
    LDS_WAIT(); asm volatile("" ::: "memory");
}
__device__ __forceinline__ int map_win(int n) {
    if (n < 1536) return n;
    if (n < 2560) return 1540 + (n - 1536);
    if (n < 4096) return 2628 + (n - 2560);
    if (n < 4160) { const int p = n - 4096, wc = p >> 5, nn = (p >> 4) & 1, r = p & 15; return 2564 + 16 * wc + r + 32 * nn; }
    if (n < 4164) return 1536 + (n - 4160);
    return -1;
}
__device__ __forceinline__ int map_uq(int n) {
    if (n < 1024) return (n >> 7) * 192 + (n & 127);
    const int p = n - 1024, head = p >> 6, pp = p & 63, w1 = pp >> 5, nn = (pp >> 4) & 1, r = pp & 15;
    return head * 192 + 128 + 16 * w1 + r + 32 * nn;
}
__device__ __forceinline__ void sincos_acc(float ang, float& s, float& c) {
    const double a = (double)ang; const double k = rint(a * 0.63661977236758134308);
    double r = fma(-k, 1.57079632679489655800e+00, a); r = fma(-k, 6.12323399573676603587e-17, r);
    const double r2 = r * r;
    double sp = -2.50521083854417187751e-08; sp = fma(sp, r2, 2.75573192239858906526e-06); sp = fma(sp, r2, -1.98412698412698412698e-04); sp = fma(sp, r2, 8.33333333333333333333e-03); sp = fma(sp, r2, -1.66666666666666666667e-01);
    const double sn = fma(r * r2, sp, r);
    double cp = 2.08767569878680989792e-09; cp = fma(cp, r2, -2.75573192239858906526e-07); cp = fma(cp, r2, 2.48015873015873015873e-05); cp = fma(cp, r2, -1.38888888888888888889e-03); cp = fma(cp, r2, 4.16666666666666666667e-02); cp = fma(cp, r2, -0.5);
    const double cs = fma(r2, cp, 1.0);
    const int q = ((int)k) & 3;
    const double ss = (q == 0) ? sn : (q == 1) ? cs : (q == 2) ? -sn : -cs;
    const double cc = (q == 0) ? cs : (q == 1) ? -sn : (q == 2) ? -cs : sn;
    s = (float)ss; c = (float)cc;
}

constexpr int NWAVES = 8;
#ifndef MK_SITE_MASK
#define MK_SITE_MASK 0xFFF
#endif
#ifndef MK_REP_MASK
#define MK_REP_MASK 0x0
#define MK_REP_N 1
#endif
#ifndef MK_EPI_REP
#define MK_EPI_REP 1
#endif
#define NREP(i) ((((MK_REP_MASK) >> (i)) & 1) ? MK_REP_N : 1)
#define REP(i) for (int rep = 0; rep < NREP(i); ++rep)
constexpr int RING_BYTES = 131072, MISC_OFF = RING_BYTES + 320, LDS_BYTES = 147456;
constexpr int NPHASE = 2 + 8 * DEPTH;

struct Args { const float* in[18]; float* out; unsigned char* ws; int ph_lo, ph_hi, use_bar, pad; };

__global__ void __launch_bounds__(NWAVES * 64, 2) mk_fwd(Args args) {
    extern __shared__ __attribute__((aligned(16))) unsigned char lds_raw[];
    LAS unsigned char* lds = (LAS unsigned char*)lds_raw;
    volatile LAS unsigned* MISC = (volatile LAS unsigned*)(lds + MISC_OFF);
    const int G = gridDim.x; const int bx = blockIdx.x; const int vcu = (G % 8 == 0) ? (bx % 8) * (G / 8) + bx / 8 : bx;
    unsigned char* ws = args.ws;
    unsigned* ctl = (unsigned*)(ws + WS_CTL);
    for (int u = threadIdx.x; u < (LDS_BYTES - RING_BYTES) / 4; u += NWAVES * 64) ((LAS unsigned*)(lds + RING_BYTES))[u] = 0u;
    __syncthreads();
    XcdBarrier bar; bar.bar = ctl + CW_BAR; bar.x = 0; bar.st = nullptr;
    if (args.use_bar) bar = xcd_barrier_post(ctl + CW_BAR, MISC + 8);
    const int lo = args.ph_lo, hi = args.ph_hi;
#define IN(k) (lo <= (k) && (k) < hi)
#define EN(i) (((MK_SITE_MASK) >> (i)) & 1)
#define SEAM(k) do { if (args.use_bar && IN((k) + 1)) xcd_barrier(bar); } while (0)

    const float* x_in = args.in[0];
    float* xres = args.out;
#define WSL GAS unsigned char* wsl = (GAS unsigned char*)ws; asm volatile("" : "+s"(wsl))
#define XB ((bf16_t*)(GAS bf16_t*)(wsl + WS_XB))
#define ACT ((bf16_t*)(GAS bf16_t*)(wsl + WS_BIG))
#define P ((bf16_t*)(GAS bf16_t*)(wsl + WS_P))
#define KR ((bf16_t*)(GAS bf16_t*)(wsl + WS_KR))
#define QBN ((bf16_t*)(GAS bf16_t*)(wsl + WS_QBN))
#define QBR ((bf16_t*)(GAS bf16_t*)(wsl + WS_QBR))
#define KVB ((bf16_t*)(GAS bf16_t*)(wsl + WS_KVB))
#define MIX ((bf16_t*)(GAS bf16_t*)(wsl + WS_MIX))
#define DILO ((bf16_t*)(GAS bf16_t*)(wsl + WS_DILO))
#define SSQ ((float*)(GAS float*)(wsl + WS_SSQ))
#define SSQQ ((float*)(GAS float*)(wsl + WS_SSQQ))
#define SSQKV ((float*)(GAS float*)(wsl + WS_SSQKV))
#define LOGF ((float*)(GAS float*)(wsl + WS_LOGF))
#define LSE ((float*)(GAS float*)(wsl + WS_LSE))
#define COSM ((float*)(GAS float*)(wsl + WS_COSM))
#define SINM ((float*)(GAS float*)(wsl + WS_SINM))
#define COSP ((float*)(GAS float*)(wsl + WS_COSP))
#define SINP ((float*)(GAS float*)(wsl + WS_SINP))
    const int NGW = G * NWAVES;
#define SITE_LANE int tid_o = threadIdx.x; asm volatile("" : "+v"(tid_o)); const int tid = tid_o, lane = tid & 63, wave = __builtin_amdgcn_readfirstlane(tid >> 6), gw = vcu * NWAVES + wave; (void)tid; (void)lane; (void)gw

    if (EN(0) && IN(0)) { WSL; SITE_LANE;
        REP(0) {
        LAS float* scr = (LAS float*)(lds + wave * 16384);
        constexpr int I_GU = (DM / 64) * (NGU / 32), I_DN = (FF / 64) * (DM / 32), I_IN = (DM / 64) * (INP / 32), I_UQ = (512 / 64) * (1536 / 32), I_UKV = (512 / 64) * (2048 / 32), I_OUT = (DM / 64) * (DM / 32);
        constexpr int I_LAYER = 2 * I_GU + 2 * I_DN + I_IN + I_UQ + I_UKV + I_OUT;
        for (int it = gw; it < DEPTH * I_LAYER; it += NGW) {
            const int l = it / I_LAYER; int r = it - l * I_LAYER;
            unsigned char* wl = ws + WS_W + (size_t)l * W_LAYER;
            const int nl = 4 * (lane & 7);
            if (r < 2 * I_GU) { const int f2 = r >= I_GU; if (f2) r -= I_GU; const int nblk = NGU / 32, kb = r / nblk, nb = r % nblk, n0 = 32 * nb;
                const int tile = n0 >> 8, within = n0 & 255; const bool up = within >= 128; const int col = tile * 128 + (within & 127) + nl;
                const float* W = args.in[(f2 ? 14 : 2) + (up ? 1 : 0)] + (size_t)l * DM * FF; const float* gain = args.in[f2 ? 13 : 1] + (size_t)l * DM;
                cvt_item(W, FF, gain, (bf16_t*)(wl + (f2 ? WO_GU2 : WO_GU1)), DM, n0, 64 * kb, col, scr, lane); continue; }
            r -= 2 * I_GU;
            if (r < 2 * I_DN) { const int f2 = r >= I_DN; if (f2) r -= I_DN; const int nblk = DM / 32, kb = r / nblk, nb = r % nblk, n0 = 32 * nb;
                const float* W = args.in[f2 ? 16 : 4] + (size_t)l * FF * DM;
                cvt_item(W, DM, nullptr, (bf16_t*)(wl + (f2 ? WO_DN2 : WO_DN1)), FF, n0, 64 * kb, n0 + nl, scr, lane); continue; }
            r -= 2 * I_DN;
            if (r < I_IN) { const int nblk = INP / 32, kb = r / nblk, nb = r % nblk, n0 = 32 * nb;
                cvt_item(args.in[6] + (size_t)l * DM * IN_W, IN_W, args.in[5] + (size_t)l * DM, (bf16_t*)(wl + WO_IN), DM, n0, 64 * kb, map_win(n0 + nl), scr, lane); continue; }
            r -= I_IN;
            if (r < I_UQ) { const int nblk = 1536 / 32, kb = r / nblk, nb = r % nblk, n0 = 32 * nb;
                cvt_item(args.in[10] + (size_t)l * 512 * 1536, 1536, args.in[8] + (size_t)l * 512, (bf16_t*)(wl + WO_UQ), 512, n0, 64 * kb, map_uq(n0 + nl), scr, lane); continue; }
            r -= I_UQ;
            if (r < I_UKV) { const int nblk = 2048 / 32, kb = r / nblk, nb = r % nblk, n0 = 32 * nb;
                cvt_item(args.in[11] + (size_t)l * 512 * 2048, 2048, args.in[9] + (size_t)l * 512, (bf16_t*)(wl + WO_UKV), 512, n0, 64 * kb, n0 + nl, scr, lane); continue; }
            r -= I_UKV;
            { const int nblk = DM / 32, kb = r / nblk, nb = r % nblk, n0 = 32 * nb;
              cvt_item(args.in[12] + (size_t)l * DM * DM, DM, nullptr, (bf16_t*)(wl + WO_OUT), DM, n0, 64 * kb, n0 + nl, scr, lane); }
        }
        for (int i = bx * (NWAVES * 64) + tid; i < SEQ * 48; i += G * NWAVES * 64) {
            const int s = i / 48, j = i % 48; float sn, cs;
            if (j < 32) { const float inv = 1.0f / powf(500000.0f, (float)(2 * j) / 64.0f); sincos_acc((float)s * inv, sn, cs); COSM[s * 32 + j] = cs; SINM[s * 32 + j] = sn; }
            else { const int jj = j - 32; const float inv = 1.0f / powf(500000.0f, (float)(2 * jj) / 32.0f); sincos_acc((float)s * inv, sn, cs); COSP[s * 16 + jj] = cs; SINP[s * 16 + jj] = sn; }
        }
        for (int m = gw; m < M; m += NGW) { const f32x4* xr = (const f32x4*)(x_in + (size_t)m * DM) + lane; float s = 0.f;
            u32x2* o8 = (u32x2*)(XB + (size_t)m * DM) + lane;
#pragma unroll
            for (int j = 0; j < 8; ++j) { const f32x4 v = xr[64 * j]; s += (v[0] * v[0] + v[1] * v[1]) + (v[2] * v[2] + v[3] * v[3]); u32x2 w; w.x = cvt_pk_bf16(v[0], v[1]); w.y = cvt_pk_bf16(v[2], v[3]); o8[64 * j] = w; }
#pragma unroll
            for (int o = 1; o < 64; o <<= 1) s += __shfl_xor(s, o);
            if (lane < 32) SSQ[(size_t)m * 32 + lane] = (lane == 0) ? s : 0.f; }
        }
        VM_WAIT(); __syncthreads();
        SEAM(0);
    }

    for (int l = 0; l < DEPTH; ++l) {
        const int pb = 1 + 8 * l;
        unsigned char* wl = ws + WS_W + (size_t)l * W_LAYER;
        for (int half = 0; half < 2; ++half) {
        if (EN(1) && IN(pb + 6 * half)) { WSL; pg8::Gemm g{XB, (const bf16_t*)(wl + (half ? WO_GU2 : WO_GU1)), DM, DM, M, NGU, DM}; pg8::EpiGateUp E{wsl}; REP(1) { pg8::StaticOrder S; S.init(M, NGU, G, bx); pg8::gemm_phase<pg8::EpiGateUp, true>(lds, g, S, E); } SEAM(pb + 6 * half); }
        if (EN(2) && IN(pb + 6 * half + 1)) { WSL; pg8::Gemm g{ACT, (const bf16_t*)(wl + (half ? WO_DN2 : WO_DN1)), 64, FF, M, DM, FF, 256 * 64 * 2, (FF / 64) * 256 * 64 * 2}; REP(2) { pg8::StaticOrder S; S.init(M, DM, G, bx, 4); pg8::EpiResid E{XB, (rep + 1 < NREP(2)) ? (bf16_t*)(GAS bf16_t*)(wsl + WS_KVB) : XB, wsl, 0.5f}; pg8::gemm_phase<pg8::EpiResid, true>(lds, g, S, E); } SEAM(pb + 6 * half + 1); }
        if (half) break;
        if (EN(3) && IN(pb + 2)) { WSL; pg8::Gemm g{XB, (const bf16_t*)(wl + WO_IN), DM, DM, M, INP, DM}; pg8::EpiWin E{wsl, args.in[7] + l * 4};
            REP(3) { pg8::StaticOrder S; S.init(M, INP, G, bx); pg8::gemm_phase<pg8::EpiWin, true>(lds, g, S, E); } SEAM(pb + 2); }
        if (IN(pb + 3)) {
            if (EN(4)) { WSL; pg8::Gemm g{P + PC_CQ, (const bf16_t*)(wl + WO_UQ), PP, 512, M, 1536, 512}; pg8::EpiUq E{wsl}; REP(4) { pg8::StaticOrder S; S.init(M, 1536, G, bx); pg8::gemm_phase<pg8::EpiUq, true>(lds, g, S, E); } }
            if (EN(5)) { WSL; pg8::Gemm g{P + PC_CKV, (const bf16_t*)(wl + WO_UKV), PP, 512, M, 2048, 512}; pg8::EpiUkv E{wsl}; REP(5) { pg8::StaticOrder S; S.init(M, 2048, G, bx); pg8::gemm_phase<pg8::EpiUkv, true>(lds, g, S, E); } }
            if (EN(6)) REP(6) for (int it = vcu; it < 1024; it += G) { WSL;
                const int br = it >> 9, i2 = it & 511, bh = i2 >> 4, sub = i2 & 15; const int b = bh >> 2, h = bh & 3;
                const int d = br ? 16 : 4; const int res = br ? sub : (sub >> 2), qb = br ? 0 : (sub & 3);
                const size_t row0 = (size_t)b * SEQ + res;
                att::Blk B{}; B.qs = (long)PP * d; B.ks = B.qs; B.vs = B.qs; B.os = 512L * d; B.ls = 4L * d; B.P0 = qb * 256; B.W = 129;
                B.Q = P + (row0 + (size_t)qb * 256 * d) * PP + PC_DQ + h * HD; B.K = P + row0 * PP + PC_DK + h * HD; B.V = P + row0 * PP + PC_DV + h * HD;
                B.O = DILO + (size_t)br * M * 512 + (row0 + (size_t)qb * 256 * d) * 512 + h * HD; B.Lo = LSE + (size_t)br * M * 4 + (row0 + (size_t)qb * 256 * d) * 4 + h;
                att::attn_block<2>(B, lds);
            }
            SEAM(pb + 3);
        }
        if (IN(pb + 4)) {
            if (EN(7)) REP(7) for (int it = vcu; it < 256; it += G) { WSL; const int bh = it >> 3, x = it & 7, b = bh >> 2, h = bh & 3;
                att::fox_bias_table(LOGF, b, h, lds);
                for (int pass = 0; pass < 2; ++pass) { const int qb = pass ? 15 - x : x; const size_t row0 = (size_t)b * SEQ;
                    att::Blk B{}; B.qs = PP; B.ks = PP; B.vs = PP; B.os = 2048; B.P0 = qb * 256; B.W = 1 << 20;
                    B.Q = P + (row0 + (size_t)qb * 256) * PP + PC_FQ + h * HD; B.K = P + row0 * PP + PC_FK + h * HD; B.V = P + row0 * PP + PC_FV + h * HD;
                    B.O = MIX + (row0 + (size_t)qb * 256) * 2048 + h * HD;
                    att::attn_block<0>(B, lds); } }
            if (EN(8)) REP(8) for (int it = vcu; it < 512; it += G) { WSL; const int bh = it >> 3, x = it & 7, b = bh >> 3, h = bh & 7;
                for (int pass = 0; pass < 2; ++pass) { const int qb = pass ? 15 - x : x; const size_t row0 = (size_t)b * SEQ;
                    att::Blk B{}; B.qs = 1024; B.qrs = 512; B.ks = 2048; B.krs = 64; B.vs = 2048; B.os = 2048; B.P0 = qb * 256; B.W = 1 << 20;
                    B.Q = QBN + (row0 + (size_t)qb * 256) * 1024 + h * HD; B.Qr = QBR + (row0 + (size_t)qb * 256) * 512 + h * 64;
                    B.K = KVB + row0 * 2048 + h * 256; B.Kr = KR + row0 * 64; B.V = KVB + row0 * 2048 + h * 256 + HD;
                    B.O = MIX + (row0 + (size_t)qb * 256) * 2048 + 512 + h * HD;
                    att::attn_block<1>(B, lds); } }
            if (EN(9)) REP(9) for (int it = vcu; it < 512; it += G) { WSL; const int bh = it >> 4, qb = it & 15, b = bh >> 2, h = bh & 3; const size_t row0 = (size_t)b * SEQ, rq = row0 + (size_t)qb * 256;
                att::Blk B{}; B.qs = PP; B.ks = PP; B.vs = PP; B.os = 2048; B.P0 = qb * 256; B.W = 129;
                B.Q = P + rq * PP + PC_DQ + h * HD; B.K = P + row0 * PP + PC_DK + h * HD; B.V = P + row0 * PP + PC_DV + h * HD;
                B.O = MIX + rq * 2048 + 1536 + h * HD;
                B.O2 = DILO + rq * 512 + h * HD; B.O3 = DILO + (size_t)M * 512 + rq * 512 + h * HD; B.L2 = LSE + rq * 4 + h; B.L3 = LSE + (size_t)M * 4 + rq * 4 + h; B.o23s = 512; B.l23s = 4;
                att::attn_block<3>(B, lds); }
            SEAM(pb + 4);
        }
        if (EN(10) && IN(pb + 5)) { WSL; pg8::Gemm g{MIX, (const bf16_t*)(wl + WO_OUT), DM, DM, M, DM, DM}; REP(10) { pg8::StaticOrder S; S.init(M, DM, G, bx, 4); pg8::EpiResid E{XB, (rep + 1 < NREP(10)) ? (bf16_t*)(GAS bf16_t*)(wsl + WS_P) : XB, wsl, 1.0f}; pg8::gemm_phase<pg8::EpiResid, true>(lds, g, S, E); } SEAM(pb + 5); }
        }
    }
    if (EN(11) && IN(NPHASE - 1)) { WSL; SITE_LANE;
        const float* gf = args.in[17];
        for (int m = gw; m < M; m += NGW) { float s = (lane < 32) ? SSQ[(size_t)m * 32 + lane] : 0.f;
#pragma unroll
            for (int o = 1; o < 64; o <<= 1) s += __shfl_xor(s, o);
            const float r = __builtin_amdgcn_rsqf(s * (1.0f / DM) + EPS);
            const u32x4* xr = (const u32x4*)(XB + (size_t)m * DM) + lane; f32x4* orow = (f32x4*)(xres + (size_t)m * DM); const f32x4* gr = (const f32x4*)gf;
#pragma unroll
            for (int j = 0; j < 4; ++j) { const u32x4 b = xr[64 * j]; const int c = (64 * j + lane) * 2;
                f32x4 v0, v1; v0[0] = __uint_as_float(b.x << 16); v0[1] = __uint_as_float(b.x & 0xffff0000u); v0[2] = __uint_as_float(b.y << 16); v0[3] = __uint_as_float(b.y & 0xffff0000u);
                v1[0] = __uint_as_float(b.z << 16); v1[1] = __uint_as_float(b.z & 0xffff0000u); v1[2] = __uint_as_float(b.w << 16); v1[3] = __uint_as_float(b.w & 0xffff0000u);
                orow[c] = v0 * r * gr[c]; orow[c + 1] = v1 * r * gr[c + 1]; } }
    }
#undef IN
#undef SEAM
#undef EN
}

#ifndef MK_ONE_LAUNCH
#define MK_ONE_LAUNCH 1
#endif
extern "C" void kernel_launch(void* const* d_in, const int* in_sizes, int n_in, void* d_out, int out_size, void* d_ws, size_t ws_size, hipStream_t stream) {
    static int grid = 0;
    if (grid == 0) {
        if (n_in != 18 || in_sizes[0] != M * DM || out_size != M * DM || ws_size < WS_END) {
            fprintf(stderr, "kernel_launch: shape/workspace mismatch (n_in %d, in0 %d, out %d, ws %zu, need %zu)\n", n_in, n_in > 0 ? in_sizes[0] : -1, out_size, ws_size, (size_t)WS_END); grid = -1; return; }
        int dev = 0, cus = 0;
        if (hipGetDevice(&dev) != hipSuccess || hipDeviceGetAttribute(&cus, hipDeviceAttributeMultiprocessorCount, dev) != hipSuccess) { grid = -1; return; }
        if (hipFuncSetAttribute((const void*)mk_fwd, hipFuncAttributeMaxDynamicSharedMemorySize, LDS_BYTES) != hipSuccess) { fprintf(stderr, "kernel_launch: hipFuncSetAttribute failed\n"); grid = -1; return; }
        int per_cu = 0;
        if (hipOccupancyMaxActiveBlocksPerMultiprocessor(&per_cu, (const void*)mk_fwd, NWAVES * 64, LDS_BYTES) != hipSuccess || per_cu < 1) fprintf(stderr, "kernel_launch: occupancy query says %d\n", per_cu);
        (void)hipGetLastError();
        grid = cus;
    }
    if (grid < 0) return;
    if (hipMemsetAsync((char*)d_ws + WS_CTL, 0, CTL_ZERO_BYTES, stream) != hipSuccess) return;
    Args a{};
    for (int i = 0; i < 18; ++i) a.in[i] = (const float*)d_in[i];
    a.out = (float*)d_out; a.ws = (unsigned char*)d_ws;
#if MK_ONE_LAUNCH
    a.ph_lo = 0; a.ph_hi = NPHASE; a.use_bar = 1;
    hipLaunchKernelGGL(mk_fwd, dim3(grid), dim3(NWAVES * 64), LDS_BYTES, stream, a);
#else
    for (int p = 0; p < NPHASE; ++p) { a.ph_lo = p; a.ph_hi = p + 1; a.use_bar = 0;
        hipLaunchKernelGGL(mk_fwd, dim3(grid), dim3(NWAVES * 64), LDS_BYTES, stream, a); }
#endif
}
```

```cpp
#include <hip/hip_runtime.h>
#include <cstdio>
#include <cstdint>

#ifndef MK_EPI_REP
#define MK_EPI_REP 1
#endif
#define LAS __attribute__((address_space(3)))
#define GAS __attribute__((address_space(1)))
typedef unsigned short bf16_t;
typedef short bf16x8 __attribute__((ext_vector_type(8)));
typedef short s16x4 __attribute__((ext_vector_type(4)));
typedef float f32x4 __attribute__((ext_vector_type(4)));
typedef float f32x2 __attribute__((ext_vector_type(2)));
typedef float f32x16 __attribute__((ext_vector_type(16)));
typedef unsigned u32x4 __attribute__((ext_vector_type(4)));
typedef unsigned u32x2 __attribute__((ext_vector_type(2)));

constexpr int BATCH = 8, SEQ = 4096, DM = 2048, DEPTH = 4, FF = 5632, HD = 128;
constexpr int M = BATCH * SEQ;
constexpr int IN_W = 4164, INP = 4352;
constexpr int NGU = 2 * FF;
constexpr float EPS = 1e-6f;
constexpr float LOG2E = 1.4426950408889634f;
constexpr float C2_FOX = 0.08838834764831845f * LOG2E;
constexpr float C2_DIL = C2_FOX;
constexpr float C2_MLA = 0.07216878364870322f * LOG2E;
constexpr int PP = 4096;
constexpr int PC_FQ = 0, PC_FK = 512, PC_FV = 1024, PC_CQ = 1536, PC_CKV = 2048, PC_DQ = 2560, PC_DK = 3072, PC_DV = 3584;

constexpr size_t MiB = 1u << 20;
constexpr size_t WS_CTL = 0, CTL_ZERO_BYTES = 1 * MiB;
constexpr size_t WS_COSM = 1 * MiB;
constexpr size_t WS_SINM = WS_COSM + 512 * 1024;
constexpr size_t WS_COSP = 2 * MiB;
constexpr size_t WS_SINP = WS_COSP + 256 * 1024;
constexpr size_t WS_SSQ = 4 * MiB;
constexpr size_t WS_SSQQ = 8 * MiB;
constexpr size_t WS_SSQKV = 9 * MiB;
constexpr size_t WS_LOGF = 10 * MiB;
constexpr size_t WS_LSE = 11 * MiB;
constexpr size_t WS_W = 16 * MiB;
constexpr size_t W_GU = (size_t)NGU * DM * 2, W_DN = (size_t)DM * FF * 2, W_IN = (size_t)INP * DM * 2, W_UQ = (size_t)1536 * 512 * 2, W_UKV = (size_t)2048 * 512 * 2, W_OUT = (size_t)DM * DM * 2;
constexpr size_t WO_GU1 = 0, WO_DN1 = WO_GU1 + W_GU, WO_IN = WO_DN1 + W_DN, WO_UQ = WO_IN + W_IN, WO_UKV = WO_UQ + W_UQ, WO_OUT = WO_UKV + W_UKV, WO_GU2 = WO_OUT + W_OUT, WO_DN2 = WO_GU2 + W_GU, W_LAYER = WO_DN2 + W_DN;
constexpr size_t WS_XB = WS_W + DEPTH * W_LAYER;
constexpr size_t WS_BIG = WS_XB + (size_t)M * DM * 2;
constexpr size_t WS_P = WS_BIG;
constexpr size_t WS_KR = WS_P + (size_t)M * PP * 2;
constexpr size_t WS_QBN = WS_KR + (size_t)M * 64 * 2;
constexpr size_t WS_QBR = WS_QBN + (size_t)M * 1024 * 2;
constexpr size_t WS_KVB = WS_QBR + (size_t)M * 512 * 2;
constexpr size_t WS_MIX = WS_KVB + (size_t)M * 2048 * 2;
constexpr size_t WS_DILO = WS_MIX + (size_t)M * 2048 * 2;
constexpr size_t WS_END = WS_DILO + (size_t)2 * M * 512 * 2;
static_assert(W_LAYER % 256 == 0 && WS_BIG + (size_t)M * FF * 2 <= WS_END, "ws map");

constexpr int CW_BAR = 4096;

typedef __bf16 bf16x2n_t __attribute__((ext_vector_type(2)));
__device__ __forceinline__ unsigned cvt_pk_bf16(float lo, float hi) { const f32x2 v = {lo, hi}; return __builtin_bit_cast(unsigned, __builtin_convertvector(v, bf16x2n_t)); }
__device__ __forceinline__ float bf2f(unsigned short h) { return __uint_as_float((unsigned)h << 16); }
#define LDS_WAIT() asm volatile("s_waitcnt lgkmcnt(0)" ::: "memory")
#define VM_WAIT() asm volatile("s_waitcnt vmcnt(0)" ::: "memory")

namespace pg8 {
constexpr int BM = 256, BK = 64, HALF = 128, HTB = HALF * BK * 2, STAGE_BYTES = 8 * HTB, NXCD = 8, WGM = 8;
__host__ __device__ __forceinline__ int lds_byte(int r, int c) { const int st = (r >> 4) * 2 + (c >> 5), rr = r & 15, cc = c & 31, ob = rr * 64 + cc * 2; return st * 1024 + (ob ^ (((ob >> 9) & 1) << 5)); }
__host__ __device__ __forceinline__ void stage_rc(int b, int& R, int& C) { const int st = b / 1024, sb = b % 1024, swz = sb ^ (((sb >> 9) & 1) << 5); R = (st >> 1) * 16 + swz / 64; C = (st & 1) * 32 + (swz % 64) / 2; }
__host__ __device__ __forceinline__ int perm32(int rho) { const int n = rho >> 4, i = rho & 15; return 8 * (i >> 2) + 4 * n + (i & 3); }
struct Unit { int pm, pn; };
struct Gemm { const bf16_t* A; const bf16_t* Bt; int lda, ldb, M, N, K; int kstepA = BK * 2, tstepA = 0; };
struct StaticOrder {
    int nM, nN, nwg, G, c, wgm;
    __host__ __device__ void init(int M_, int N_, int G_, int c_, int wgm_ = WGM) { nM = M_ / BM; nN = N_ / BM; nwg = nM * nN; G = G_; c = c_; wgm = wgm_; }
    __host__ __device__ bool next(int i, Unit& u) const {
        const long L = (long)i * G + c; if (L >= nwg) return false;
        int wgid = (int)L; { const int q = nwg / NXCD, r = nwg % NXCD, xcd = wgid % NXCD, off = wgid / NXCD; wgid = (xcd < r ? xcd * (q + 1) : r * (q + 1) + (xcd - r) * q) + off; }
        const int nig = wgm * nN, gid = wgid / nig, fm = gid * wgm, gsz = (nM - fm) < wgm ? (nM - fm) : wgm;
        u.pm = fm + ((wgid % nig) % gsz); u.pn = (wgid % nig) / gsz; return true;
    }
};
template <class Epi, bool ALIGN_EPI>
__device__ __forceinline__ void gemm_phase(LAS unsigned char* lds, const Gemm g, const StaticOrder& S, const Epi& E) {
    int tid_o = threadIdx.x; asm volatile("" : "+v"(tid_o));
    const int tid = tid_o, wid = __builtin_amdgcn_readfirstlane(tid >> 6), lane = tid & 63, wr = wid >> 2, wc = wid & 3, fr = lane & 15, fq = lane >> 4;
    const int K = g.K, nt = K / BK;
    unsigned voffA[2], voffB[2];
#pragma unroll
    for (int i = 0; i < 2; ++i) { int R, C; stage_rc(tid * 16 + i * 8192, R, C); const int Rb = Epi::PERM ? ((R & ~31) + perm32(R & 31)) : R;
        voffA[i] = (unsigned)(R * g.lda + C) * 2u; voffB[i] = (unsigned)(Rb * g.ldb + C) * 2u; }
    const size_t kstep = (size_t)(BK * 2), kstepA = (size_t)g.kstepA;
    const size_t hstepA = (size_t)HALF * g.lda * 2, hstepB = (size_t)HALF * g.ldb * 2;
    const size_t tstepA = g.tstepA ? (size_t)g.tstepA : 2 * hstepA, tstepB = 2 * hstepB;
    const unsigned ldsw = (unsigned)wid * 1024u;
    const __amdgpu_buffer_rsrc_t srdA = __builtin_amdgcn_make_buffer_rsrc((void*)g.A, (short)0, 0x7fffffff, 0x00020000), srdB = __builtin_amdgcn_make_buffer_rsrc((void*)g.Bt, (short)0, 0x7fffffff, 0x00020000);
    const int aoff = lds_byte(wr * 64 + fr, fq * 8), boff = lds_byte(wc * 32 + fr, fq * 8);
#define PG8_SA(b, h) (((b) * 2 + (h)) * HTB)
#define PG8_SB(b, h) ((4 + (b) * 2 + (h)) * HTB)
#define PG8_STAGE(srd, base0, bufoff, gbase, voff) do { const unsigned so_ = (unsigned)((const char*)(gbase) - (const char*)(base0)); _Pragma("unroll") for (int _i = 0; _i < 2; ++_i) \
        __builtin_amdgcn_raw_ptr_buffer_load_lds(srd, (LAS void*)(lds + (bufoff) + ldsw + _i * 8192), 16, (int)(voff)[_i], (int)so_, 0, 0); } while (0)
#define PG8_LDA(dst, b, h) do { _Pragma("unroll") for (int m = 0; m < 4; ++m) _Pragma("unroll") for (int k = 0; k < 2; ++k) dst[m][k] = *(const LAS bf16x8*)(lds + PG8_SA(b, h) + aoff + m * 2048 + k * 1024); } while (0)
#define PG8_LDB(dst, b, h) do { _Pragma("unroll") for (int n = 0; n < 2; ++n) _Pragma("unroll") for (int k = 0; k < 2; ++k) dst[n][k] = *(const LAS bf16x8*)(lds + PG8_SB(b, h) + boff + n * 2048 + k * 1024); } while (0)
#define PG8_MMA(ai, bj, At, Bt) do { __builtin_amdgcn_s_setprio(1); _Pragma("unroll") for (int m = 0; m < 4; ++m) _Pragma("unroll") for (int n = 0; n < 2; ++n) _Pragma("unroll") for (int k = 0; k < 2; ++k) \
        acc[ai][bj][m][n] = __builtin_amdgcn_mfma_f32_16x16x32_bf16(Bt[n][k], At[m][k], acc[ai][bj][m][n], 0, 0, 0); __builtin_amdgcn_s_setprio(0); } while (0)
#define PG8_WAIT_V(n) asm volatile("s_waitcnt vmcnt(" #n ")" ::: "memory")
#define PG8_WAIT_L(n) asm volatile("s_waitcnt lgkmcnt(" #n ")" ::: "memory")
#define PG8_BAR __builtin_amdgcn_s_barrier()
#define PG8_SCHED __builtin_amdgcn_sched_barrier(0)
    Unit cur, nxt; int ui = 0;
    if (!S.next(0, cur)) return;
    __builtin_amdgcn_s_waitcnt(0x0F70);
    LAS float* rc = (LAS float*)(lds + STAGE_BYTES + 1024) + wid * 144;
    *(volatile LAS int*)(rc + 128) = -1;
    f32x4 acc[2][2][4][2];
#pragma unroll
    for (int a = 0; a < 2; ++a)
#pragma unroll
        for (int b = 0; b < 2; ++b)
#pragma unroll
            for (int m = 0; m < 4; ++m)
#pragma unroll
                for (int n = 0; n < 2; ++n) acc[a][b][m][n] = (f32x4){0.f, 0.f, 0.f, 0.f};
    bf16x8 At[4][2], B0[2][2], B1[2][2];
    const char* cA = (const char*)g.A + (size_t)cur.pm * tstepA; const char* cB = (const char*)g.Bt + (size_t)cur.pn * tstepB;
    PG8_STAGE(srdB, g.Bt, PG8_SB(0, 0), cB, voffB); PG8_STAGE(srdB, g.Bt, PG8_SB(0, 1), cB + hstepB, voffB); PG8_STAGE(srdA, g.A, PG8_SA(0, 0), cA, voffA); PG8_STAGE(srdA, g.A, PG8_SA(0, 1), cA + hstepA, voffA);
    if (wr == 1) PG8_BAR;
    PG8_WAIT_V(2); PG8_BAR;
    PG8_STAGE(srdB, g.Bt, PG8_SB(1, 0), cB + kstep, voffB); PG8_STAGE(srdA, g.A, PG8_SA(1, 0), cA + kstepA, voffA); PG8_STAGE(srdB, g.Bt, PG8_SB(1, 1), cB + hstepB + kstep, voffB);
    PG8_WAIT_V(6); PG8_BAR;
    for (;;) {
        const bool has_next = S.next(ui + 1, nxt);
        const char* nA = has_next ? (const char*)g.A + (size_t)nxt.pm * tstepA : cA; const char* nB = has_next ? (const char*)g.Bt + (size_t)nxt.pn * tstepB : cB;
        for (int t = 0; t < nt; t += 2) {
            const bool last = (t == nt - 2);
            const char* a1 = cA + (size_t)(t + 1) * kstepA;
            const char* a2 = last ? nA : cA + (size_t)(t + 2) * kstepA; const char* b2 = last ? nB : cB + (size_t)(t + 2) * kstep;
            const char* a3 = a2 + kstepA; const char* b3 = b2 + kstep;
            PG8_LDB(B0, 0, 0); PG8_LDB(B1, 0, 1); PG8_SCHED; PG8_LDA(At, 0, 0); PG8_STAGE(srdA, g.A, PG8_SA(1, 1), a1 + hstepA, voffA);
            PG8_WAIT_V(8); PG8_WAIT_L(0); PG8_BAR; PG8_MMA(0, 0, At, B0); PG8_MMA(0, 1, At, B1); PG8_BAR; PG8_SCHED;
            PG8_LDA(At, 0, 1); PG8_STAGE(srdB, g.Bt, PG8_SB(0, 0), b2, voffB); PG8_STAGE(srdB, g.Bt, PG8_SB(0, 1), b2 + hstepB, voffB); PG8_STAGE(srdA, g.A, PG8_SA(0, 0), a2, voffA);
            PG8_WAIT_V(8); PG8_WAIT_L(0); PG8_BAR; PG8_MMA(1, 0, At, B0); PG8_MMA(1, 1, At, B1); PG8_BAR; PG8_SCHED;
            PG8_LDB(B0, 1, 0); PG8_LDB(B1, 1, 1); PG8_SCHED; PG8_LDA(At, 1, 0); PG8_STAGE(srdA, g.A, PG8_SA(0, 1), a2 + hstepA, voffA);
            PG8_WAIT_V(8); PG8_WAIT_L(0); PG8_BAR; PG8_MMA(0, 0, At, B0); PG8_MMA(0, 1, At, B1); PG8_BAR; PG8_SCHED;
            PG8_LDA(At, 1, 1); PG8_STAGE(srdB, g.Bt, PG8_SB(1, 0), b3, voffB); PG8_STAGE(srdB, g.Bt, PG8_SB(1, 1), b3 + hstepB, voffB); PG8_STAGE(srdA, g.A, PG8_SA(1, 0), a3, voffA);
            PG8_WAIT_V(8); PG8_WAIT_L(0); PG8_BAR; PG8_MMA(1, 0, At, B0); PG8_MMA(1, 1, At, B1); PG8_BAR; PG8_SCHED;
        }
        if constexpr (ALIGN_EPI) { if (wr == 0) PG8_BAR; }
        E(acc, cur, wr, wc, fr, fq, rc);
        if constexpr (Epi::EREP > 1) { for (int er_ = 1; er_ < Epi::EREP; ++er_) { asm volatile("" ::: "memory"); E(acc, cur, wr, wc, fr, fq, rc); } }
        if (!has_next) break;
#pragma unroll
        for (int a = 0; a < 2; ++a)
#pragma unroll
            for (int b = 0; b < 2; ++b)
#pragma unroll
                for (int m = 0; m < 4; ++m)
#pragma unroll
                    for (int n = 0; n < 2; ++n) acc[a][b][m][n] = (f32x4){0.f, 0.f, 0.f, 0.f};
        cur = nxt; cA = nA; cB = nB; ++ui;
        if constexpr (ALIGN_EPI) { if (wr == 1) PG8_BAR; }
    }
    PG8_WAIT_V(0);
    if constexpr (!ALIGN_EPI) { if (wr == 0) PG8_BAR; }
    PG8_BAR;
#undef PG8_SA
#undef PG8_SB
#undef PG8_STAGE
#undef PG8_LDA
#undef PG8_LDB
#undef PG8_MMA
#undef PG8_WAIT_V
#undef PG8_WAIT_L
#undef PG8_BAR
#undef PG8_SCHED
}

__device__ __forceinline__ float xrow16_sum(float x) {
    auto s = __builtin_amdgcn_permlane16_swap(__float_as_uint(x), __float_as_uint(x), false, false);
    x = __uint_as_float(s[0]) + __uint_as_float(s[1]);
    auto t = __builtin_amdgcn_permlane32_swap(__float_as_uint(x), __float_as_uint(x), false, false);
    return __uint_as_float(t[0]) + __uint_as_float(t[1]);
}
template <int NP> __device__ __forceinline__ void load_rstd(const float* ssq, int row0, int fq, float inv_n, float (&rs)[2][4]) {
    float sv[8];
    if constexpr (NP == 32) {
#pragma unroll
        for (int h = 0; h < 2; ++h) { f32x4 a[4], b[4];
#pragma unroll
            for (int i = 0; i < 4; ++i) { const float* p = ssq + (size_t)(row0 + h * HALF + i * 16) * 32 + 8 * fq; a[i] = *(const f32x4*)p; b[i] = *(const f32x4*)(p + 4); }
#pragma unroll
            for (int i = 0; i < 4; ++i) sv[4 * h + i] = ((a[i][0] + a[i][1]) + (a[i][2] + a[i][3])) + ((b[i][0] + b[i][1]) + (b[i][2] + b[i][3]));
            asm volatile("" ::: "memory"); }
    } else { f32x2 a[8];
#pragma unroll
        for (int i = 0; i < 8; ++i) a[i] = *(const f32x2*)(ssq + (size_t)(row0 + (i >> 2) * HALF + (i & 3) * 16) * 8 + 2 * fq);
#pragma unroll
        for (int i = 0; i < 8; ++i) sv[i] = a[i][0] + a[i][1];
    }
#pragma unroll
    for (int i = 0; i < 8; ++i) sv[i] = xrow16_sum(sv[i]);
#pragma unroll
    for (int i = 0; i < 8; ++i) rs[i >> 2][i & 3] = __builtin_amdgcn_rsqf(sv[i] * inv_n + EPS);
}
template <int NP> __device__ __forceinline__ void load_rstd_cached(const float* ssq, int row0, int fq, int fr, float inv_n, float (&rs)[2][4], LAS float* rc, int pm) {
    const int tag = __builtin_amdgcn_readfirstlane(*(volatile LAS int*)(rc + 128));
    if (tag == pm) {
#pragma unroll
        for (int i = 0; i < 8; ++i) rs[i >> 2][i & 3] = rc[i * 16 + fr];
    } else {
        load_rstd<NP>(ssq, row0, fq, inv_n, rs);
        if (fq == 0) {
#pragma unroll
            for (int i = 0; i < 8; ++i) rc[i * 16 + fr] = rs[i >> 2][i & 3]; }
        *(volatile LAS int*)(rc + 128) = pm;
    }
}
struct EpiGateUp {
    static constexpr bool PERM = true; static constexpr int EREP = MK_EPI_REP;
    GAS unsigned char* ws;
    __device__ __forceinline__ void operator()(const f32x4 (&acc)[2][2][4][2], const Unit& u, int wr, int wc, int fr, int fq, LAS float* rc) const {
        bf16_t* O = (bf16_t*)(GAS bf16_t*)(ws + WS_BIG); const float* ssq = (const float*)(GAS float*)(ws + WS_SSQ);
        const int row0 = u.pm * BM + wr * 64 + fr, col0 = u.pn * HALF + wc * 32 + 8 * fq;
        float rs[2][4]; load_rstd_cached<32>(ssq, row0, fq, fr, 1.0f / DM, rs, rc, u.pm);
#pragma unroll
        for (int ai = 0; ai < 2; ++ai)
#pragma unroll
            for (int m = 0; m < 4; ++m) { const float r = rs[ai][m], c1 = -r * LOG2E, R = __builtin_amdgcn_rcpf(r * r); f32x2 t[4], gu[4];
#pragma unroll
                for (int i = 0; i < 4; ++i) { const f32x2 g = {acc[ai][0][m][i >> 1][2 * (i & 1)], acc[ai][0][m][i >> 1][2 * (i & 1) + 1]}, uu = {acc[ai][1][m][i >> 1][2 * (i & 1)], acc[ai][1][m][i >> 1][2 * (i & 1) + 1]};
                    t[i] = g * c1; gu[i] = g * uu; }
#pragma unroll
                for (int i = 0; i < 4; ++i) { t[i].x = __builtin_amdgcn_exp2f(t[i].x); t[i].y = __builtin_amdgcn_exp2f(t[i].y); }
#pragma unroll
                for (int i = 0; i < 4; ++i) { t[i].x = __builtin_fmaf(t[i].x, R, R); t[i].y = __builtin_fmaf(t[i].y, R, R); }
#pragma unroll
                for (int i = 0; i < 4; ++i) { t[i].x = __builtin_amdgcn_rcpf(t[i].x); t[i].y = __builtin_amdgcn_rcpf(t[i].y); }
#pragma unroll
                for (int i = 0; i < 4; ++i) gu[i] = gu[i] * t[i];
                u32x4 w; w.x = cvt_pk_bf16(gu[0].x, gu[0].y); w.y = cvt_pk_bf16(gu[1].x, gu[1].y); w.z = cvt_pk_bf16(gu[2].x, gu[2].y); w.w = cvt_pk_bf16(gu[3].x, gu[3].y);
                { const int row = row0 + ai * HALF + m * 16;
                  *(u32x4*)(O + ((size_t)((row >> 8) * (FF / 64) + (col0 >> 6)) * 256 + (row & 255)) * 64 + (col0 & 63)) = w; } }
    }
};
struct EpiResid {
    static constexpr bool PERM = true; static constexpr int EREP = 1;
    const bf16_t* base; bf16_t* outb; GAS unsigned char* ws; float scale;
    __device__ __forceinline__ void operator()(const f32x4 (&acc)[2][2][4][2], const Unit& u, int wr, int wc, int fr, int fq, LAS float* rc) const {
        float* ssq = (float*)(GAS float*)(ws + WS_SSQ);
        const int row0 = u.pm * BM + wr * 64 + fr, col0 = u.pn * BM + wc * 32 + 8 * fq;
#pragma unroll
        for (int hb = 0; hb < 2; ++hb) {
        u32x4 pre[4][2];
#pragma unroll
        for (int g4 = 0; g4 < 4; ++g4) { const size_t off = (size_t)(row0 + hb * HALF + g4 * 16) * DM + col0;
            pre[g4][0] = *(const u32x4*)(base + off); pre[g4][1] = *(const u32x4*)(base + off + HALF); }
#pragma unroll
        for (int g4 = 0; g4 < 4; ++g4) { const int ai = hb, m = g4, row = row0 + ai * HALF + m * 16; const size_t off = (size_t)row * DM + col0; float sq = 0.f;
            f32x2 sq2 = {0.f, 0.f};
#pragma unroll
            for (int bj = 0; bj < 2; ++bj) { const u32x4 b = pre[g4][bj];
                f32x2 x0 = {__uint_as_float(b.x << 16), __uint_as_float(b.x & 0xffff0000u)}, x1 = {__uint_as_float(b.y << 16), __uint_as_float(b.y & 0xffff0000u)};
                f32x2 x2 = {__uint_as_float(b.z << 16), __uint_as_float(b.z & 0xffff0000u)}, x3 = {__uint_as_float(b.w << 16), __uint_as_float(b.w & 0xffff0000u)};
                const f32x4 a0 = acc[ai][bj][m][0], a1 = acc[ai][bj][m][1];
                x0 = x0 + (f32x2){a0[0], a0[1]} * scale; x1 = x1 + (f32x2){a0[2], a0[3]} * scale; x2 = x2 + (f32x2){a1[0], a1[1]} * scale; x3 = x3 + (f32x2){a1[2], a1[3]} * scale;
                u32x4 w; w.x = cvt_pk_bf16(x0.x, x0.y); w.y = cvt_pk_bf16(x1.x, x1.y); w.z = cvt_pk_bf16(x2.x, x2.y); w.w = cvt_pk_bf16(x3.x, x3.y);
                *(u32x4*)(outb + off + bj * HALF) = w;
                sq2 = sq2 + x0 * x0; sq2 = sq2 + x1 * x1; sq2 = sq2 + x2 * x2; sq2 = sq2 + x3 * x3; }
            sq = sq2.x + sq2.y;
            sq = xrow16_sum(sq); if (fq == 0) ssq[(size_t)row * 32 + u.pn * 4 + wc] = sq; }
        asm volatile("" ::: "memory"); }
    }
};
struct EpiWin {
    static constexpr bool PERM = false; static constexpr int EREP = 1;
    GAS unsigned char* ws; const float* fbias;
    __device__ __forceinline__ void operator()(const f32x4 (&acc)[2][2][4][2], const Unit& u, int wr, int wc, int fr, int fq, LAS float* rc) const {
        bf16_t* P = (bf16_t*)(GAS bf16_t*)(ws + WS_P); bf16_t* KR = (bf16_t*)(GAS bf16_t*)(ws + WS_KR); float* logf = (float*)(GAS float*)(ws + WS_LOGF); const float* ssq = (const float*)(GAS float*)(ws + WS_SSQ);
        float* ssqq = (float*)(GAS float*)(ws + WS_SSQQ); float* ssqkv = (float*)(GAS float*)(ws + WS_SSQKV);
        const float* cosp = (const float*)(GAS float*)(ws + WS_COSP); const float* sinp = (const float*)(GAS float*)(ws + WS_SINP); const float* cosm = (const float*)(GAS float*)(ws + WS_COSM); const float* sinm = (const float*)(GAS float*)(ws + WS_SINM);
        const int row0 = u.pm * BM + wr * 64 + fr;
        float rs[2][4]; load_rstd_cached<32>(ssq, row0, fq, fr, 1.0f / DM, rs, rc, u.pm);
        const int pn = u.pn, grp = pn >> 1;
        if (pn < 16) {
            const float sc = (grp == 0) ? C2_FOX : (grp == 5) ? C2_DIL : 1.0f;
            const bool rope = (grp == 5 || grp == 6) && wc == 0;
            float* sq_dst = (grp == 3) ? ssqq : (grp == 4) ? ssqkv : nullptr;
#pragma unroll
            for (int ai = 0; ai < 2; ++ai)
#pragma unroll
                for (int m = 0; m < 4; ++m) { const int row = row0 + ai * HALF + m * 16; const float r = rs[ai][m]; const int s = row & (SEQ - 1); float sq = 0.f;
#pragma unroll
                    for (int bj = 0; bj < 2; ++bj) { f32x4 v0 = acc[ai][bj][m][0] * r, v1 = acc[ai][bj][m][1] * r;
                        sq += (v0[0] * v0[0] + v0[1] * v0[1]) + (v0[2] * v0[2] + v0[3] * v0[3]) + (v1[0] * v1[0] + v1[1] * v1[1]) + (v1[2] * v1[2] + v1[3] * v1[3]);
                        if (rope) { const f32x4 c = *(const f32x4*)(cosp + s * 16 + 4 * fq), sn = *(const f32x4*)(sinp + s * 16 + 4 * fq);
                            const f32x4 a = v0 * c - v1 * sn, b = v0 * sn + v1 * c; v0 = a; v1 = b; }
                        v0 = v0 * sc; v1 = v1 * sc;
                        bf16_t* p = P + (size_t)row * PP + pn * BM + bj * HALF + wc * 32 + 4 * fq;
                        u32x2 w0, w1; w0.x = cvt_pk_bf16(v0[0], v0[1]); w0.y = cvt_pk_bf16(v0[2], v0[3]); w1.x = cvt_pk_bf16(v1[0], v1[1]); w1.y = cvt_pk_bf16(v1[2], v1[3]);
                        *(u32x2*)p = w0; *(u32x2*)(p + 16) = w1; }
                    if (sq_dst) { sq = xrow16_sum(sq); if (fq == 0) sq_dst[(size_t)row * 8 + (pn & 1) * 4 + wc] = sq; } }
        } else {
            if (wc < 2) {
#pragma unroll
                for (int ai = 0; ai < 2; ++ai)
#pragma unroll
                    for (int m = 0; m < 4; ++m) { const int row = row0 + ai * HALF + m * 16; const float r = rs[ai][m]; const int s = row & (SEQ - 1); const int d = 16 * wc + 4 * fq;
                        const f32x4 x1 = acc[ai][0][m][0] * r, x2 = acc[ai][0][m][1] * r;
                        const f32x4 c = *(const f32x4*)(cosm + s * 32 + d), sn = *(const f32x4*)(sinm + s * 32 + d);
                        const f32x4 a = x1 * c - x2 * sn, b = x1 * sn + x2 * c;
                        u32x2 w0, w1; w0.x = cvt_pk_bf16(a[0], a[1]); w0.y = cvt_pk_bf16(a[2], a[3]); w1.x = cvt_pk_bf16(b[0], b[1]); w1.y = cvt_pk_bf16(b[2], b[3]);
                        *(u32x2*)(KR + (size_t)row * 64 + d) = w0; *(u32x2*)(KR + (size_t)row * 64 + d + 32) = w1; }
            } else if (wc == 2 && fq == 0) {
                const f32x4 fb = *(const f32x4*)fbias;
#pragma unroll
                for (int ai = 0; ai < 2; ++ai)
#pragma unroll
                    for (int m = 0; m < 4; ++m) { const int row = row0 + ai * HALF + m * 16; const f32x4 z = acc[ai][0][m][0] * rs[ai][m] + fb; f32x4 o;
#pragma unroll
                        for (int j = 0; j < 4; ++j) { const float az = fabsf(z[j]); o[j] = fminf(z[j], 0.f) - log1pf(__expf(-az)); }
                        *(f32x4*)(logf + (size_t)row * 4) = o; }
            }
        }
    }
};
struct EpiUq {
    static constexpr bool PERM = false; static constexpr int EREP = 1;
    GAS unsigned char* ws;
    __device__ __forceinline__ void operator()(const f32x4 (&acc)[2][2][4][2], const Unit& u, int wr, int wc, int fr, int fq, LAS float* rc) const {
        bf16_t* QBn = (bf16_t*)(GAS bf16_t*)(ws + WS_QBN); bf16_t* QBr = (bf16_t*)(GAS bf16_t*)(ws + WS_QBR); const float* ssqq = (const float*)(GAS float*)(ws + WS_SSQQ);
        const float* cosm = (const float*)(GAS float*)(ws + WS_COSM); const float* sinm = (const float*)(GAS float*)(ws + WS_SINM);
        const int row0 = u.pm * BM + wr * 64 + fr;
        float rs[2][4]; load_rstd<8>(ssqq, row0, fq, 1.0f / 512, rs);
        const int pn = u.pn;
#pragma unroll
        for (int ai = 0; ai < 2; ++ai)
#pragma unroll
            for (int m = 0; m < 4; ++m) { const int row = row0 + ai * HALF + m * 16; const float r = rs[ai][m] * C2_MLA; const int s = row & (SEQ - 1);
#pragma unroll
                for (int bj = 0; bj < 2; ++bj) { const f32x4 v0 = acc[ai][bj][m][0] * r, v1 = acc[ai][bj][m][1] * r;
                    if (pn < 4) { bf16_t* p = QBn + (size_t)row * 1024 + pn * BM + bj * HALF + wc * 32 + 4 * fq;
                        u32x2 w0, w1; w0.x = cvt_pk_bf16(v0[0], v0[1]); w0.y = cvt_pk_bf16(v0[2], v0[3]); w1.x = cvt_pk_bf16(v1[0], v1[1]); w1.y = cvt_pk_bf16(v1[2], v1[3]);
                        *(u32x2*)p = w0; *(u32x2*)(p + 16) = w1; }
                    else { const int head = (pn - 4) * 4 + 2 * bj + (wc >> 1), d = 16 * (wc & 1) + 4 * fq;
                        const f32x4 c = *(const f32x4*)(cosm + s * 32 + d), sn = *(const f32x4*)(sinm + s * 32 + d);
                        const f32x4 a = v0 * c - v1 * sn, b = v0 * sn + v1 * c;
                        u32x2 w0, w1; w0.x = cvt_pk_bf16(a[0], a[1]); w0.y = cvt_pk_bf16(a[2], a[3]); w1.x = cvt_pk_bf16(b[0], b[1]); w1.y = cvt_pk_bf16(b[2], b[3]);
                        bf16_t* p = QBr + (size_t)row * 512 + head * 64 + d; *(u32x2*)p = w0; *(u32x2*)(p + 32) = w1; } } }
    }
};
struct EpiUkv {
    static constexpr bool PERM = true; static constexpr int EREP = 1;
    GAS unsigned char* ws;
    __device__ __forceinline__ void operator()(const f32x4 (&acc)[2][2][4][2], const Unit& u, int wr, int wc, int fr, int fq, LAS float* rc) const {
        bf16_t* KVB = (bf16_t*)(GAS bf16_t*)(ws + WS_KVB); const float* ssqkv = (const float*)(GAS float*)(ws + WS_SSQKV);
        const int row0 = u.pm * BM + wr * 64 + fr, col0 = u.pn * BM + wc * 32 + 8 * fq;
        float rs[2][4]; load_rstd<8>(ssqkv, row0, fq, 1.0f / 512, rs);
#pragma unroll
        for (int ai = 0; ai < 2; ++ai)
#pragma unroll
            for (int m = 0; m < 4; ++m) { const float r = rs[ai][m]; bf16_t* rowp = KVB + (size_t)(row0 + ai * HALF + m * 16) * 2048 + col0;
#pragma unroll
                for (int bj = 0; bj < 2; ++bj) { const f32x4 v0 = acc[ai][bj][m][0] * r, v1 = acc[ai][bj][m][1] * r;
                    u32x4 w; w.x = cvt_pk_bf16(v0[0], v0[1]); w.y = cvt_pk_bf16(v0[2], v0[3]); w.z = cvt_pk_bf16(v1[0], v1[1]); w.w = cvt_pk_bf16(v1[2], v1[3]);
                    *(u32x4*)(rowp + bj * HALF) = w; } }
    }
};
}

namespace att {
#define SBAR() __builtin_amdgcn_sched_barrier(0)
constexpr int SHM = 16384, SHMR = 8192;
constexpr int SHMV = SHM;
constexpr int OFF_V = 0, OFF_K = 3 * SHMV, OFF_KR = OFF_K + 3 * SHM, OFF_CUM = OFF_KR, ATT_LDS = OFF_KR + 3 * SHMR, OFF_WS = 131072 + 8192;
constexpr float THR2 = 24.0f;
static_assert(ATT_LDS <= 131072, "attention LDS");
__device__ __forceinline__ int kswz(int row, int colB) { return row * 256 + (colB ^ ((row & 15) << 4)); }
__device__ __forceinline__ int krswz(int row, int chunk) { return row * 128 + ((chunk ^ ((row >> 1) & 7)) << 4); }
typedef short v4i16_t __attribute__((ext_vector_type(4)));
__device__ __forceinline__ s16x4 vtr(const LAS unsigned char* p) { return __builtin_bit_cast(s16x4, __builtin_amdgcn_ds_read_tr16_b64_v4i16((LAS v4i16_t*)p)); }
__device__ __forceinline__ float xrow16_max(float x) {
    auto s = __builtin_amdgcn_permlane16_swap(__float_as_uint(x), __float_as_uint(x), false, false);
    x = fmaxf(__uint_as_float(s[0]), __uint_as_float(s[1]));
    auto t = __builtin_amdgcn_permlane32_swap(__float_as_uint(x), __float_as_uint(x), false, false);
    return fmaxf(__uint_as_float(t[0]), __uint_as_float(t[1]));
}
template <int OFF> __device__ __forceinline__ s16x4 vtra(unsigned a) { s16x4 r; asm volatile("ds_read_b64_tr_b16 %0, %1 offset:%2" : "=v"(r) : "v"(a), "n"(OFF) : "memory"); return r; }
__device__ __forceinline__ f32x4 mf16(bf16x8 a, bf16x8 b, f32x4 c) { return __builtin_amdgcn_mfma_f32_16x16x32_bf16(a, b, c, 0, 0, 0); }

struct Blk {
    const bf16_t* Q; long qs;
    const bf16_t* Qr; long qrs;
    const bf16_t* K; long ks;
    const bf16_t* Kr; long krs;
    const bf16_t* V; long vs;
    bf16_t* O; long os;
    float* Lo; long ls;
    const bf16_t* O2; const bf16_t* O3; const float* L2; const float* L3; long o23s; long l23s;
    int P0; int W;
};
template <int MODE>
__device__ __forceinline__ void attn_block(const Blk& B, LAS unsigned char* lds) {
    int tid_o = threadIdx.x; asm volatile("" : "+v"(tid_o));
    const int tid = tid_o, wid = __builtin_amdgcn_readfirstlane(tid >> 6), lane = tid & 63, fr = lane & 15, fq = lane >> 4;
    LAS unsigned char* V_lds = lds + OFF_V; LAS unsigned char* K_lds = lds + OFF_K; LAS unsigned char* KR_lds = lds + OFF_KR;
    const LAS float* biasL = (const LAS float*)(lds + OFF_CUM);
    bf16x8 qf[2][4]; bf16x8 qrf[2][2];
#pragma unroll
    for (int c = 0; c < 2; ++c) { const bf16_t* qp = B.Q + (long)(wid * 32 + 16 * c + fr) * B.qs + fq * 8;
#pragma unroll
        for (int s_ = 0; s_ < 4; ++s_) qf[c][s_] = *(const bf16x8*)(qp + 32 * s_);
        if constexpr (MODE == 1) { const bf16_t* qp2 = B.Qr + (long)(wid * 32 + 16 * c + fr) * B.qrs + fq * 8;
#pragma unroll
            for (int s_ = 0; s_ < 2; ++s_) qrf[c][s_] = *(const bf16x8*)(qp2 + 32 * s_); } }
    const int W = B.W, P0 = B.P0;
    const int lowk = P0 - W + 1; const int j_lo = lowk > 0 ? lowk / 64 : 0; const int j_hi = (P0 + 255) / 64 + 1;
    const int qpos0 = P0 + wid * 32 + fr;
    float m0 = -1e30f, m1 = -1e30f, l0 = 0.f, l1 = 0.f;
    f32x4 oacc[8][2];
#pragma unroll
    for (int d = 0; d < 8; ++d) { oacc[d][0] = f32x4{0.f, 0.f, 0.f, 0.f}; oacc[d][1] = f32x4{0.f, 0.f, 0.f, 0.f}; }
    const int dr = 8 * wid + (lane >> 4);
    const int kof0 = ((lane & 15) ^ (dr & 15)) * 8, kof1 = ((lane & 15) ^ ((dr + 4) & 15)) * 8;
    const int vof0 = ((((lane & 15) >> 1) ^ (dr & 7)) * 16) + (lane & 1) * 8, vof1 = ((((lane & 15) >> 1) ^ ((dr + 4) & 7)) * 16) + (lane & 1) * 8;
    const int rr = 8 * wid + (lane >> 3); const int rof = ((lane & 7) ^ ((rr >> 1) & 7)) * 8;
    constexpr int NDMA = (MODE == 1) ? 5 : 4;
    const __amdgpu_buffer_rsrc_t srK = __builtin_amdgcn_make_buffer_rsrc((void*)B.K, (short)0, 0x7fffffff, 0x00020000), srV = __builtin_amdgcn_make_buffer_rsrc((void*)B.V, (short)0, 0x7fffffff, 0x00020000);
    const __amdgpu_buffer_rsrc_t srR = __builtin_amdgcn_make_buffer_rsrc((void*)(MODE == 1 ? B.Kr : B.K), (short)0, 0x7fffffff, 0x00020000);
    const int ko0 = (int)((dr * B.ks + kof0) * 2), ko1 = (int)(((dr + 4) * B.ks + kof1) * 2), vo0 = (int)((dr * B.vs + vof0) * 2), vo1 = (int)(((dr + 4) * B.vs + vof1) * 2), ro0 = (int)((rr * B.krs + rof) * 2);
    const int kts = (int)(B.ks * 128), vts = (int)(B.vs * 128), rts = (int)(B.krs * 128);
#define T_DMA_K(t_, b_) do { const int so_ = (t_) * kts; \
        __builtin_amdgcn_raw_ptr_buffer_load_lds(srK, (LAS void*)(K_lds + (b_) * SHM + wid * 2048), 16, ko0, so_, 0, 0); \
        __builtin_amdgcn_raw_ptr_buffer_load_lds(srK, (LAS void*)(K_lds + (b_) * SHM + wid * 2048 + 1024), 16, ko1, so_, 0, 0); } while (0)
#define T_DMA_V(t_, b_) do { const int so_ = (t_) * vts; \
        __builtin_amdgcn_raw_ptr_buffer_load_lds(srV, (LAS void*)(V_lds + (b_) * SHMV + wid * 2048), 16, vo0, so_, 0, 0); \
        __builtin_amdgcn_raw_ptr_buffer_load_lds(srV, (LAS void*)(V_lds + (b_) * SHMV + wid * 2048 + 1024), 16, vo1, so_, 0, 0); } while (0)
#define T_DMA_R(t_, b_) do { if constexpr (MODE == 1) __builtin_amdgcn_raw_ptr_buffer_load_lds(srR, (LAS void*)(KR_lds + (b_) * SHMR + wid * 1024), 16, ro0, (t_) * rts, 0, 0); } while (0)
#define T_DMA(t_, b_) do { T_DMA_K(t_, b_); T_DMA_V(t_, b_); T_DMA_R(t_, b_); } while (0)
#define T_LANDED() do { if constexpr (MODE == 1) asm volatile("s_waitcnt vmcnt(5)" ::: "memory"); else asm volatile("s_waitcnt vmcnt(4)" ::: "memory"); } while (0)
    int vpb[8];
#pragma unroll
    for (int d = 0; d < 8; ++d) vpb[d] = (4 * fq + (fr >> 2)) * 256 + ((d ^ (4 * (fq & 1) + (fr >> 2))) * 32) + (fr & 3) * 8;
#define PK8(S0_, S1_, OUT) do { u32x4 w_ = {cvt_pk_bf16(S0_[0], S0_[1]), cvt_pk_bf16(S0_[2], S0_[3]), cvt_pk_bf16(S1_[0], S1_[1]), cvt_pk_bf16(S1_[2], S1_[3])}; OUT = __builtin_bit_cast(bf16x8, w_); } while (0)
#define VLD(L_, H_, d0) do { const unsigned a0_ = vp_ + (unsigned)vpb[2 * (d0)], a1_ = vp_ + (unsigned)vpb[2 * (d0) + 1]; \
        L_[0] = vtra<0>(a0_); H_[0] = vtra<4096>(a0_); L_[1] = vtra<8192>(a0_); H_[1] = vtra<12288>(a0_); L_[2] = vtra<0>(a1_); H_[2] = vtra<4096>(a1_); L_[3] = vtra<8192>(a1_); H_[3] = vtra<12288>(a1_); } while (0)
#define LWAIT8(L_, H_) asm volatile("s_waitcnt lgkmcnt(0)" : "+v"(L_[0]), "+v"(L_[1]), "+v"(L_[2]), "+v"(L_[3]), "+v"(H_[0]), "+v"(H_[1]), "+v"(H_[2]), "+v"(H_[3]) :: "memory")
#define VFR(L_, H_, k_) (bf16x8){L_[k_][0], L_[k_][1], L_[k_][2], L_[k_][3], H_[k_][0], H_[k_][1], H_[k_][2], H_[k_][3]}
#define VMF(L_, H_, d0) do { oacc[2 * (d0)][0] = mf16(VFR(L_, H_, 0), pb00, oacc[2 * (d0)][0]); oacc[2 * (d0)][1] = mf16(VFR(L_, H_, 0), pb01, oacc[2 * (d0)][1]); \
        oacc[2 * (d0) + 1][0] = mf16(VFR(L_, H_, 2), pb00, oacc[2 * (d0) + 1][0]); oacc[2 * (d0) + 1][1] = mf16(VFR(L_, H_, 2), pb01, oacc[2 * (d0) + 1][1]); \
        oacc[2 * (d0)][0] = mf16(VFR(L_, H_, 1), pb10, oacc[2 * (d0)][0]); oacc[2 * (d0)][1] = mf16(VFR(L_, H_, 1), pb11, oacc[2 * (d0)][1]); \
        oacc[2 * (d0) + 1][0] = mf16(VFR(L_, H_, 3), pb10, oacc[2 * (d0) + 1][0]); oacc[2 * (d0) + 1][1] = mf16(VFR(L_, H_, 3), pb11, oacc[2 * (d0) + 1][1]); } while (0)
#define PV_ALL(buf_) do { const unsigned vp_ = (unsigned)(size_t)(V_lds + (buf_) * SHMV); s16x4 la_[4], ha_[4], lb_[4], hb_[4]; \
        SBAR(); VLD(la_, ha_, 0); VLD(lb_, hb_, 1); LWAIT8(la_, ha_); LWAIT8(lb_, hb_); SBAR(); \
        VMF(la_, ha_, 0); VLD(la_, ha_, 2); SBAR(); \
        VMF(lb_, hb_, 1); VLD(lb_, hb_, 3); LWAIT8(la_, ha_); LWAIT8(lb_, hb_); SBAR(); \
        VMF(la_, ha_, 2); SBAR(); VMF(lb_, hb_, 3); SBAR(); } while (0)
#define KLD(F_, Kb_, s_) do { const LAS unsigned char* a_ = (Kb_) + kswz(fr, (32 * (s_) + 8 * fq) * 2); \
        F_[0] = *(const LAS bf16x8*)a_; F_[1] = *(const LAS bf16x8*)(a_ + 4096); F_[2] = *(const LAS bf16x8*)(a_ + 8192); F_[3] = *(const LAS bf16x8*)(a_ + 12288); } while (0)
#define KMF(F_, s_) do { sa0[0] = mf16(F_[0], qf[0][s_], sa0[0]); sa0[1] = mf16(F_[0], qf[1][s_], sa0[1]); sa1[0] = mf16(F_[1], qf[0][s_], sa1[0]); sa1[1] = mf16(F_[1], qf[1][s_], sa1[1]); \
        sa2[0] = mf16(F_[2], qf[0][s_], sa2[0]); sa2[1] = mf16(F_[2], qf[1][s_], sa2[1]); sa3[0] = mf16(F_[3], qf[0][s_], sa3[0]); sa3[1] = mf16(F_[3], qf[1][s_], sa3[1]); } while (0)
#define KRLD(F_, Kb_, s_) do { const LAS unsigned char* a_ = (Kb_) + krswz(fr, 4 * (s_) + fq); \
        F_[0] = *(const LAS bf16x8*)a_; F_[1] = *(const LAS bf16x8*)(a_ + 2048); F_[2] = *(const LAS bf16x8*)(a_ + 4096); F_[3] = *(const LAS bf16x8*)(a_ + 6144); } while (0)
#define KRMF(F_, s_) do { sa0[0] = mf16(F_[0], qrf[0][s_], sa0[0]); sa0[1] = mf16(F_[0], qrf[1][s_], sa0[1]); sa1[0] = mf16(F_[1], qrf[0][s_], sa1[0]); sa1[1] = mf16(F_[1], qrf[1][s_], sa1[1]); \
        sa2[0] = mf16(F_[2], qrf[0][s_], sa2[0]); sa2[1] = mf16(F_[2], qrf[1][s_], sa2[1]); sa3[0] = mf16(F_[3], qrf[0][s_], sa3[0]); sa3[1] = mf16(F_[3], qrf[1][s_], sa3[1]); } while (0)
    const int NT = j_hi - j_lo;
    const int qlo = P0 + wid * 32;
    bf16x8 pb00 = {}, pb01 = {}, pb10 = {}, pb11 = {};
    T_DMA(j_lo, 0);
    asm volatile("s_waitcnt vmcnt(0)" ::: "memory");
    __syncthreads();
    T_DMA((j_lo + 1 < j_hi) ? j_lo + 1 : j_hi - 1, 1);
    int cur = 0;
    for (int i = 0; i < NT; ++i) {
        const int t = j_lo + i, kb = t * 64;
        const int nxt = (cur == 2) ? 0 : cur + 1, nx2 = (cur == 0) ? 2 : cur - 1;
        const int t_ld = (t + 2 < j_hi) ? t + 2 : j_hi - 1;
        const bool need = (kb <= qlo + 31) && (kb + 63 > qlo - W);
        if (need) {
        f32x4 sa0[2], sa1[2], sa2[2], sa3[2];
#pragma unroll
        for (int c = 0; c < 2; ++c) { sa0[c] = f32x4{0.f, 0.f, 0.f, 0.f}; sa1[c] = f32x4{0.f, 0.f, 0.f, 0.f}; sa2[c] = f32x4{0.f, 0.f, 0.f, 0.f}; sa3[c] = f32x4{0.f, 0.f, 0.f, 0.f}; }
        { const LAS unsigned char* Kb = K_lds + cur * SHM; bf16x8 ka_[4], kb_[4];
          SBAR(); KLD(ka_, Kb, 0); KLD(kb_, Kb, 1); SBAR();
          KMF(ka_, 0); KLD(ka_, Kb, 2); SBAR();
          KMF(kb_, 1); KLD(kb_, Kb, 3); SBAR();
          if constexpr (MODE == 1) { const LAS unsigned char* Krb = KR_lds + cur * SHMR;
              KMF(ka_, 2); KRLD(ka_, Krb, 0); SBAR();
              KMF(kb_, 3); KRLD(kb_, Krb, 1); T_DMA_K(t_ld, nx2); SBAR();
              KRMF(ka_, 0); T_DMA_V(t_ld, nx2); SBAR(); KRMF(kb_, 1); T_DMA_R(t_ld, nx2); SBAR();
          } else { KMF(ka_, 2); T_DMA_K(t_ld, nx2); SBAR(); KMF(kb_, 3); T_DMA_V(t_ld, nx2); SBAR(); } }
        if constexpr (MODE == 0) {
            const f32x4 b0 = *(const LAS f32x4*)(biasL + kb + 4 * fq), b1 = *(const LAS f32x4*)(biasL + kb + 16 + 4 * fq), b2 = *(const LAS f32x4*)(biasL + kb + 32 + 4 * fq), b3 = *(const LAS f32x4*)(biasL + kb + 48 + 4 * fq);
#pragma unroll
            for (int c = 0; c < 2; ++c) { sa0[c] += b0; sa1[c] += b1; sa2[c] += b2; sa3[c] += b3; } }
        if (kb + 63 > qlo || kb <= qlo + 31 - W) { const int dq = qpos0 - kb - 4 * fq; const float NEG = -__builtin_inff();
#pragma unroll
          for (int c = 0; c < 2; ++c)
#pragma unroll
            for (int ii = 0; ii < 4; ++ii) { const int e = dq + 16 * c - ii;
              if ((unsigned)(e) >= (unsigned)W) sa0[c][ii] = NEG;
              if ((unsigned)(e - 16) >= (unsigned)W) sa1[c][ii] = NEG;
              if ((unsigned)(e - 32) >= (unsigned)W) sa2[c][ii] = NEG;
              if ((unsigned)(e - 48) >= (unsigned)W) sa3[c][ii] = NEG; } }
        float pm0, pm1;
        { f32x4 x0 = sa0[0], x1 = sa0[1];
#pragma unroll
          for (int ii = 0; ii < 4; ++ii) { x0[ii] = fmaxf(fmaxf(x0[ii], sa1[0][ii]), fmaxf(sa2[0][ii], sa3[0][ii])); x1[ii] = fmaxf(fmaxf(x1[ii], sa1[1][ii]), fmaxf(sa2[1][ii], sa3[1][ii])); }
          pm0 = fmaxf(fmaxf(x0[0], x0[1]), fmaxf(x0[2], x0[3])); pm1 = fmaxf(fmaxf(x1[0], x1[1]), fmaxf(x1[2], x1[3])); }
        float mn0, mn1, al0, al1;
        if (__builtin_expect(__all(fmaxf(pm0 - m0, pm1 - m1) <= THR2), 1)) { mn0 = m0; mn1 = m1; al0 = 1.f; al1 = 1.f; }
        else { pm0 = xrow16_max(pm0); pm1 = xrow16_max(pm1); mn0 = fmaxf(m0, pm0); al0 = __builtin_amdgcn_exp2f(m0 - mn0); m0 = mn0; mn1 = fmaxf(m1, pm1); al1 = __builtin_amdgcn_exp2f(m1 - mn1); m1 = mn1; }
#pragma unroll
        for (int ii = 0; ii < 4; ++ii) {
            sa0[0][ii] = __builtin_amdgcn_exp2f(sa0[0][ii] - mn0); sa1[0][ii] = __builtin_amdgcn_exp2f(sa1[0][ii] - mn0); sa2[0][ii] = __builtin_amdgcn_exp2f(sa2[0][ii] - mn0); sa3[0][ii] = __builtin_amdgcn_exp2f(sa3[0][ii] - mn0);
            sa0[1][ii] = __builtin_amdgcn_exp2f(sa0[1][ii] - mn1); sa1[1][ii] = __builtin_amdgcn_exp2f(sa1[1][ii] - mn1); sa2[1][ii] = __builtin_amdgcn_exp2f(sa2[1][ii] - mn1); sa3[1][ii] = __builtin_amdgcn_exp2f(sa3[1][ii] - mn1); }
        { f32x4 y0 = (sa0[0] + sa1[0]) + (sa2[0] + sa3[0]), y1 = (sa0[1] + sa1[1]) + (sa2[1] + sa3[1]);
          l0 = l0 * al0 + ((y0[0] + y0[1]) + (y0[2] + y0[3])); l1 = l1 * al1 + ((y1[0] + y1[1]) + (y1[2] + y1[3])); }
        PK8(sa0[0], sa1[0], pb00); PK8(sa0[1], sa1[1], pb01); PK8(sa2[0], sa3[0], pb10); PK8(sa2[1], sa3[1], pb11);
        if (__any(al0 < 1.f || al1 < 1.f)) {
#pragma unroll
            for (int d = 0; d < 8; ++d) { oacc[d][0] *= al0; oacc[d][1] *= al1; } }
        PV_ALL(cur);
        } else T_DMA(t_ld, nx2);
        T_LANDED();
        __syncthreads();
        cur = nxt;
    }
    asm volatile("s_waitcnt vmcnt(0)" ::: "memory");
#undef PV_ALL
#undef VMF
#undef VFR
#undef VLD
#undef LWAIT8
#undef KLD
#undef KMF
#undef KRLD
#undef KRMF
#undef PK8
#undef T_DMA
#undef T_DMA_K
#undef T_DMA_V
#undef T_DMA_R
#undef T_LANDED
    l0 = pg8::xrow16_sum(l0); l1 = pg8::xrow16_sum(l1);
    float lsum[2] = {l0, l1}, mrow[2] = {m0, m1};
#pragma unroll
    for (int c = 0; c < 2; ++c) {
        const long qi = wid * 32 + 16 * c + fr;
        const float lse2 = mrow[c] + __builtin_amdgcn_logf(lsum[c]);
        float wgt = __builtin_amdgcn_rcpf(lsum[c]); float w2 = 0.f, w3 = 0.f;
        if constexpr (MODE == 2) { if (fq == 0) B.Lo[qi * B.ls] = lse2; }
        if constexpr (MODE == 3) { const float a2 = B.L2[qi * B.l23s], a3 = B.L3[qi * B.l23s];
            const float mx = fmaxf(lse2, fmaxf(a2, a3)); const float e1 = __builtin_amdgcn_exp2f(lse2 - mx), e2 = __builtin_amdgcn_exp2f(a2 - mx), e3 = __builtin_amdgcn_exp2f(a3 - mx);
            const float inv = __builtin_amdgcn_rcpf(e1 + e2 + e3); wgt = e1 * inv * wgt; w2 = e2 * inv; w3 = e3 * inv; }
        bf16_t* Ow = B.O + qi * B.os + 4 * fq;
#pragma unroll
        for (int d = 0; d < 8; ++d) { f32x4 v = oacc[d][c] * wgt;
            if constexpr (MODE == 3) { const long po = qi * B.o23s + 16 * d + 4 * fq; const u32x2 u2 = *(const u32x2*)(B.O2 + po), u3 = *(const u32x2*)(B.O3 + po);
                v[0] += w2 * __uint_as_float(u2.x << 16) + w3 * __uint_as_float(u3.x << 16); v[1] += w2 * __uint_as_float(u2.x & 0xffff0000u) + w3 * __uint_as_float(u3.x & 0xffff0000u);
                v[2] += w2 * __uint_as_float(u2.y << 16) + w3 * __uint_as_float(u3.y << 16); v[3] += w2 * __uint_as_float(u2.y & 0xffff0000u) + w3 * __uint_as_float(u3.y & 0xffff0000u); }
            u32x2 w; w.x = cvt_pk_bf16(v[0], v[1]); w.y = cvt_pk_bf16(v[2], v[3]); *(u32x2*)(Ow + 16 * d) = w; } }
    __syncthreads();
}
__device__ __forceinline__ void fox_bias_table(const float* logf, int b, int h, LAS unsigned char* lds) {
    int tid_o = threadIdx.x; asm volatile("" : "+v"(tid_o));
    const int tid = tid_o, wid = tid >> 6, lane = tid & 63;
    LAS float* biasL = (LAS float*)(lds + OFF_CUM); LAS float* wsum = (LAS float*)(lds + OFF_WS);
    float v[8]; float run = 0.f;
#pragma unroll
    for (int i = 0; i < 8; ++i) { run += logf[((size_t)b * SEQ + 8 * tid + i) * 4 + h]; v[i] = run; }
    float sc = run;
#pragma unroll
    for (int o = 1; o < 64; o <<= 1) { const float n = __shfl_up(sc, o); if (lane >= o) sc += n; }
    const float excl = sc - run;
    __syncthreads();
    if (lane == 63) wsum[wid] = sc;
    __syncthreads();
    float wpre = 0.f;
    for (int w = 0; w < wid; ++w) wpre += wsum[w];
#pragma unroll
    for (int i = 0; i < 8; ++i) biasL[8 * tid + i] = -(v[i] + excl + wpre) * LOG2E;
    __syncthreads();
}
#undef SBAR
}

#define XB_TMO      128
#define XB_XCNT(j)  (256  + 64 * (j))
#define XB_XSUB(j)  (1280 + 64 * (j))
#define XB_XGEN(j)  (2304 + 64 * (j))
#define XB_TOP      3328
#define XB_TOPGEN   3392
#define XCD_BAR_WORDS 3456
#define XB_SPIN_CAP (1u << 18)
__device__ __forceinline__ unsigned xb_ld(unsigned* p)              { return __hip_atomic_load(p, __ATOMIC_RELAXED, __HIP_MEMORY_SCOPE_AGENT); }
__device__ __forceinline__ unsigned xb_add(unsigned* p, unsigned v) { return __hip_atomic_fetch_add(p, v, __ATOMIC_RELAXED, __HIP_MEMORY_SCOPE_AGENT); }
__device__ __forceinline__ unsigned xb_xcc_id() { return (unsigned)__builtin_amdgcn_s_getreg((3 << 11) | 20) & 0xFu; }
#define XB_SPIN(cond, bar) do { unsigned _sp = 0; while (cond) { __builtin_amdgcn_s_sleep(1); \
    if ((++_sp & 255u) == 0u) { if (xb_ld(&(bar)[XB_TMO])) break; if (_sp > XB_SPIN_CAP) { atomicAdd(&(bar)[XB_TMO], 1u); break; } } } } while (0)
struct XcdBarrier { unsigned* bar; unsigned x; volatile LAS unsigned* st; };
__device__ __forceinline__ XcdBarrier xcd_barrier_post(unsigned* bar, volatile LAS unsigned* st) {
    XcdBarrier b; b.bar = bar; b.x = xb_xcc_id(); b.st = st;
    if (threadIdx.x == 0) (void)xb_add(&bar[XB_XCNT(b.x)], 1u);
    return b;
}
__device__ __forceinline__ void xcd_barrier_complete(unsigned* bar, unsigned x, unsigned& nloc, unsigned& nx) {
    const unsigned G = gridDim.x * gridDim.y * gridDim.z;
    unsigned sum, cnt, mine, sp = 0u;
    for (;;) {
        sum = 0u; cnt = 0u; mine = 0u;
#pragma unroll
        for (unsigned j = 0; j < 16; ++j) { const unsigned c = xb_ld(&bar[XB_XCNT(j)]); sum += c; cnt += (c > 0u) ? 1u : 0u; mine = (j == x) ? c : mine; }
        if (sum == G) break;
        __builtin_amdgcn_s_sleep(1);
        if ((++sp & 255u) == 0u) { if (xb_ld(&bar[XB_TMO])) break; if (sp > XB_SPIN_CAP) { atomicAdd(&bar[XB_TMO], 1u); break; } }
    }
    nloc = mine > 0u ? mine : 1u; nx = cnt > 0u ? cnt : 1u;
}
__device__ __forceinline__ void xcd_barrier(const XcdBarrier& b) {
    asm volatile("s_waitcnt vmcnt(0)" ::: "memory");
    __syncthreads();
    if (threadIdx.x == 0) {
        unsigned* bar = b.bar;
        __builtin_amdgcn_s_waitcnt(0);
        unsigned nloc = b.st[0], nx = b.st[1];
        if (nloc == 0u) { xcd_barrier_complete(bar, b.x, nloc, nx); b.st[0] = nloc; b.st[1] = nx; }
        const unsigned old = xb_add(&bar[XB_XSUB(b.x)], 1u);
        const unsigned gen = old / nloc;
        if (old + 1u == (gen + 1u) * nloc) {
            __builtin_amdgcn_fence(__ATOMIC_RELEASE, "agent");
            asm volatile("s_waitcnt vmcnt(0)" ::: "memory");
            const unsigned og = xb_add(&bar[XB_TOP], 1u);
            const unsigned tg = og / nx;
            if (og + 1u == (tg + 1u) * nx) xb_add(&bar[XB_TOPGEN], 1u);
            else XB_SPIN(xb_ld(&bar[XB_TOPGEN]) == tg, bar);
            __builtin_amdgcn_fence(__ATOMIC_ACQUIRE, "agent");
            xb_add(&bar[XB_XGEN(b.x)], 1u);
            asm volatile("s_waitcnt vmcnt(0)" ::: "memory");
        } else {
            XB_SPIN(xb_ld(&bar[XB_XGEN(b.x)]) == gen, bar);
            __builtin_amdgcn_fence(__ATOMIC_ACQUIRE, "agent");
            asm volatile("s_waitcnt vmcnt(0)" ::: "memory");
        }
    }
    __syncthreads();
}

__device__ __forceinline__ unsigned f2bf(float f) { unsigned u = __builtin_bit_cast(unsigned, f); return (u + 0x7fffu + ((u >> 16) & 1u)) >> 16; }
__device__ __forceinline__ unsigned pk2(float lo, float hi) { return cvt_pk_bf16(lo, hi); }
__device__ __forceinline__ void cvt_item(const float* W, int ldw, const float* gain, bf16_t* WT, int K, int n0, int k0, int src4, LAS float* scr, int lane) {
    const int kq = lane >> 3, c4 = lane & 7;
    f32x4 v[8]; float g[8];
#pragma unroll
    for (int i = 0; i < 8; ++i) { v[i] = (src4 >= 0) ? *(const f32x4*)(W + (size_t)(k0 + 8 * i + kq) * ldw + src4) : (f32x4){0.f, 0.f, 0.f, 0.f}; g[i] = gain ? gain[k0 + 8 * i + kq] : 1.0f; }
#pragma unroll
    for (int i = 0; i < 8; ++i) { LAS float* d = scr + (8 * i + kq) * 33 + 4 * c4; const f32x4 w = v[i] * g[i]; d[0] = w[0]; d[1] = w[1]; d[2] = w[2]; d[3] = w[3]; }
    LDS_WAIT(); asm volatile("" ::: "memory");
    const int c = lane & 7;
#pragma unroll
    for (int j = 0; j < 4; ++j) { const int n = (lane >> 3) + 8 * j; const LAS float* s = scr + (8 * c) * 33 + n;
        u32x4 o; o.x = pk2(s[0 * 33], s[1 * 33]); o.y = pk2(s[2 * 33], s[3 * 33]); o.z = pk2(s[4 * 33], s[5 * 33]); o.w = pk2(s[6 * 33], s[7 * 33]);
        *(u32x4*)(WT + (size_t)(n0 + n) * K + k0 + 8 * c) = o; }
    LDS_WAIT(); asm volatile("" ::: "memory");
}
__device__ __forceinline__ int map_win(int n) {
    if (n < 1536) return n;
    if (n < 2560) return 1540 + (n - 1536);
    if (n < 4096) return 2628 + (n - 2560);
    if (n < 4160) { const int p = n - 4096, wc = p >> 5, nn = (p >> 4) & 1, r = p & 15; return 2564 + 16 * wc + r + 32 * nn; }
    if (n < 4164) return 1536 + (n - 4160);
    return -1;
}
__device__ __forceinline__ int map_uq(int n) {
    if (n < 1024) return (n >> 7) * 192 + (n & 127);
    const int p = n - 1024, head = p >> 6, pp = p & 63, w1 = pp >> 5, nn = (pp >> 4) & 1, r = pp & 15;
    return head * 192 + 128 + 16 * w1 + r + 32 * nn;
}
__device__ __forceinline__ void sincos_acc(float ang, float& s, float& c) {
    const double a = (double)ang; const double k = rint(a * 0.63661977236758134308);
    double r = fma(-k, 1.57079632679489655800e+00, a); r = fma(-k, 6.12323399573676603587e-17, r);
    const double r2 = r * r;
    double sp = -2.50521083854417187751e-08; sp = fma(sp, r2, 2.75573192239858906526e-06); sp = fma(sp, r2, -1.98412698412698412698e-04); sp = fma(sp, r2, 8.33333333333333333333e-03); sp = fma(sp, r2, -1.66666666666666666667e-01);
    const double sn = fma(r * r2, sp, r);
    double cp = 2.08767569878680989792e-09; cp = fma(cp, r2, -2.75573192239858906526e-07); cp = fma(cp, r2, 2.48015873015873015873e-05); cp = fma(cp, r2, -1.38888888888888888889e-03); cp = fma(cp, r2, 4.16666666666666666667e-02); cp = fma(cp, r2, -0.5);
    const double cs = fma(r2, cp, 1.0);
    const int q = ((int)k) & 3;
    const double ss = (q == 0) ? sn : (q == 1) ? cs : (q == 2) ? -sn : -cs;
    const double cc = (q == 0) ? cs : (q == 1) ? -sn : (q == 2) ? -cs : sn;
    s = (float)ss; c = (float)cc;
}

constexpr int NWAVES = 8;
#ifndef MK_SITE_MASK
#define MK_SITE_MASK 0xFFF
#endif
#ifndef MK_REP_MASK
#define MK_REP_MASK 0x0
#define MK_REP_N 1
#endif
#ifndef MK_EPI_REP
#define MK_EPI_REP 1
#endif
#define NREP(i) ((((MK_REP_MASK) >> (i)) & 1) ? MK_REP_N : 1)
#define REP(i) for (int rep = 0; rep < NREP(i); ++rep)
constexpr int RING_BYTES = 131072, MISC_OFF = RING_BYTES + 320, LDS_BYTES = 147456;
constexpr int NPHASE = 2 + 8 * DEPTH;

struct Args { const float* in[18]; float* out; unsigned char* ws; int ph_lo, ph_hi, use_bar, pad; };

__global__ void __launch_bounds__(NWAVES * 64, 2) mk_fwd(Args args) {
    extern __shared__ __attribute__((aligned(16))) unsigned char lds_raw[];
    LAS unsigned char* lds = (LAS unsigned char*)lds_raw;
    volatile LAS unsigned* MISC = (volatile LAS unsigned*)(lds + MISC_OFF);
    const int G = gridDim.x; const int bx = blockIdx.x; const int vcu = (G % 8 == 0) ? (bx % 8) * (G / 8) + bx / 8 : bx;
    unsigned char* ws = args.ws;
    unsigned* ctl = (unsigned*)(ws + WS_CTL);
    for (int u = threadIdx.x; u < (LDS_BYTES - RING_BYTES) / 4; u += NWAVES * 64) ((LAS unsigned*)(lds + RING_BYTES))[u] = 0u;
    __syncthreads();
    XcdBarrier bar; bar.bar = ctl + CW_BAR; bar.x = 0; bar.st = nullptr;
    if (args.use_bar) bar = xcd_barrier_post(ctl + CW_BAR, MISC + 8);
    const int lo = args.ph_lo, hi = args.ph_hi;
#define IN(k) (lo <= (k) && (k) < hi)
#define EN(i) (((MK_SITE_MASK) >> (i)) & 1)
#define SEAM(k) do { if (args.use_bar && IN((k) + 1)) xcd_barrier(bar); } while (0)

    const float* x_in = args.in[0];
    float* xres = args.out;
#define WSL GAS unsigned char* wsl = (GAS unsigned char*)ws; asm volatile("" : "+s"(wsl))
#define XB ((bf16_t*)(GAS bf16_t*)(wsl + WS_XB))
#define ACT ((bf16_t*)(GAS bf16_t*)(wsl + WS_BIG))
#define P ((bf16_t*)(GAS bf16_t*)(wsl + WS_P))
#define KR ((bf16_t*)(GAS bf16_t*)(wsl + WS_KR))
#define QBN ((bf16_t*)(GAS bf16_t*)(wsl + WS_QBN))
#define QBR ((bf16_t*)(GAS bf16_t*)(wsl + WS_QBR))
#define KVB ((bf16_t*)(GAS bf16_t*)(wsl + WS_KVB))
#define MIX ((bf16_t*)(GAS bf16_t*)(wsl + WS_MIX))
#define DILO ((bf16_t*)(GAS bf16_t*)(wsl + WS_DILO))
#define SSQ ((float*)(GAS float*)(wsl + WS_SSQ))
#define SSQQ ((float*)(GAS float*)(wsl + WS_SSQQ))
#define SSQKV ((float*)(GAS float*)(wsl + WS_SSQKV))
#define LOGF ((float*)(GAS float*)(wsl + WS_LOGF))
#define LSE ((float*)(GAS float*)(wsl + WS_LSE))
#define COSM ((float*)(GAS float*)(wsl + WS_COSM))
#define SINM ((float*)(GAS float*)(wsl + WS_SINM))
#define COSP ((float*)(GAS float*)(wsl + WS_COSP))
#define SINP ((float*)(GAS float*)(wsl + WS_SINP))
    const int NGW = G * NWAVES;
#define SITE_LANE int tid_o = threadIdx.x; asm volatile("" : "+v"(tid_o)); const int tid = tid_o, lane = tid & 63, wave = __builtin_amdgcn_readfirstlane(tid >> 6), gw = vcu * NWAVES + wave; (void)tid; (void)lane; (void)gw

    if (EN(0) && IN(0)) { WSL; SITE_LANE;
        REP(0) {
        LAS float* scr = (LAS float*)(lds + wave * 16384);
        constexpr int I_GU = (DM / 64) * (NGU / 32), I_DN = (FF / 64) * (DM / 32), I_IN = (DM / 64) * (INP / 32), I_UQ = (512 / 64) * (1536 / 32), I_UKV = (512 / 64) * (2048 / 32), I_OUT = (DM / 64) * (DM / 32);
        constexpr int I_LAYER = 2 * I_GU + 2 * I_DN + I_IN + I_UQ + I_UKV + I_OUT;
        for (int it = gw; it < DEPTH * I_LAYER; it += NGW) {
            const int l = it / I_LAYER; int r = it - l * I_LAYER;
            unsigned char* wl = ws + WS_W + (size_t)l * W_LAYER;
            const int nl = 4 * (lane & 7);
            if (r < 2 * I_GU) { const int f2 = r >= I_GU; if (f2) r -= I_GU; const int nblk = NGU / 32, kb = r / nblk, nb = r % nblk, n0 = 32 * nb;
                const int tile = n0 >> 8, within = n0 & 255; const bool up = within >= 128; const int col = tile * 128 + (within & 127) + nl;
                const float* W = args.in[(f2 ? 14 : 2) + (up ? 1 : 0)] + (size_t)l * DM * FF; const float* gain = args.in[f2 ? 13 : 1] + (size_t)l * DM;
                cvt_item(W, FF, gain, (bf16_t*)(wl + (f2 ? WO_GU2 : WO_GU1)), DM, n0, 64 * kb, col, scr, lane); continue; }
            r -= 2 * I_GU;
            if (r < 2 * I_DN) { const int f2 = r >= I_DN; if (f2) r -= I_DN; const int nblk = DM / 32, kb = r / nblk, nb = r % nblk, n0 = 32 * nb;
                const float* W = args.in[f2 ? 16 : 4] + (size_t)l * FF * DM;
                cvt_item(W, DM, nullptr, (bf16_t*)(wl + (f2 ? WO_DN2 : WO_DN1)), FF, n0, 64 * kb, n0 + nl, scr, lane); continue; }
            r -= 2 * I_DN;
            if (r < I_IN) { const int nblk = INP / 32, kb = r / nblk, nb = r % nblk, n0 = 32 * nb;
                cvt_item(args.in[6] + (size_t)l * DM * IN_W, IN_W, args.in[5] + (size_t)l * DM, (bf16_t*)(wl + WO_IN), DM, n0, 64 * kb, map_win(n0 + nl), scr, lane); continue; }
            r -= I_IN;
            if (r < I_UQ) { const int nblk = 1536 / 32, kb = r / nblk, nb = r % nblk, n0 = 32 * nb;
                cvt_item(args.in[10] + (size_t)l * 512 * 1536, 1536, args.in[8] + (size_t)l * 512, (bf16_t*)(wl + WO_UQ), 512, n0, 64 * kb, map_uq(n0 + nl), scr, lane); continue; }
            r -= I_UQ;
            if (r < I_UKV) { const int nblk = 2048 / 32, kb = r / nblk, nb = r % nblk, n0 = 32 * nb;
                cvt_item(args.in[11] + (size_t)l * 512 * 2048, 2048, args.in[9] + (size_t)l * 512, (bf16_t*)(wl + WO_UKV), 512, n0, 64 * kb, n0 + nl, scr, lane); continue; }
            r -= I_UKV;
            { const int nblk = DM / 32, kb = r / nblk, nb = r % nblk, n0 = 32 * nb;
              cvt_item(args.in[12] + (size_t)l * DM * DM, DM, nullptr, (bf16_t*)(wl + WO_OUT), DM, n0, 64 * kb, n0 + nl, scr, lane); }
        }
        for (int i = bx * (NWAVES * 64) + tid; i < SEQ * 48; i += G * NWAVES * 64) {
            const int s = i / 48, j = i % 48; float sn, cs;
            if (j < 32) { const float inv = 1.0f / powf(500000.0f, (float)(2 * j) / 64.0f); sincos_acc((float)s * inv, sn, cs); COSM[s * 32 + j] = cs; SINM[s * 32 + j] = sn; }
            else { const int jj = j - 32; const float inv = 1.0f / powf(500000.0f, (float)(2 * jj) / 32.0f); sincos_acc((float)s * inv, sn, cs); COSP[s * 16 + jj] = cs; SINP[s * 16 + jj] = sn; }
        }
        for (int m = gw; m < M; m += NGW) { const f32x4* xr = (const f32x4*)(x_in + (size_t)m * DM) + lane; float s = 0.f;
            u32x2* o8 = (u32x2*)(XB + (size_t)m * DM) + lane;
#pragma unroll
            for (int j = 0; j < 8; ++j) { const f32x4 v = xr[64 * j]; s += (v[0] * v[0] + v[1] * v[1]) + (v[2] * v[2] + v[3] * v[3]); u32x2 w; w.x = cvt_pk_bf16(v[0], v[1]); w.y = cvt_pk_bf16(v[2], v[3]); o8[64 * j] = w; }
#pragma unroll
            for (int o = 1; o < 64; o <<= 1) s += __shfl_xor(s, o);
            if (lane < 32) SSQ[(size_t)m * 32 + lane] = (lane == 0) ? s : 0.f; }
        }
        VM_WAIT(); __syncthreads();
        SEAM(0);
    }

    for (int l = 0; l < DEPTH; ++l) {
        const int pb = 1 + 8 * l;
        unsigned char* wl = ws + WS_W + (size_t)l * W_LAYER;
        for (int half = 0; half < 2; ++half) {
        if (EN(1) && IN(pb + 6 * half)) { WSL; pg8::Gemm g{XB, (const bf16_t*)(wl + (half ? WO_GU2 : WO_GU1)), DM, DM, M, NGU, DM}; pg8::EpiGateUp E{wsl}; REP(1) { pg8::StaticOrder S; S.init(M, NGU, G, bx); pg8::gemm_phase<pg8::EpiGateUp, true>(lds, g, S, E); } SEAM(pb + 6 * half); }
        if (EN(2) && IN(pb + 6 * half + 1)) { WSL; pg8::Gemm g{ACT, (const bf16_t*)(wl + (half ? WO_DN2 : WO_DN1)), 64, FF, M, DM, FF, 256 * 64 * 2, (FF / 64) * 256 * 64 * 2}; REP(2) { pg8::StaticOrder S; S.init(M, DM, G, bx, 4); pg8::EpiResid E{XB, (rep + 1 < NREP(2)) ? (bf16_t*)(GAS bf16_t*)(wsl + WS_KVB) : XB, wsl, 0.5f}; pg8::gemm_phase<pg8::EpiResid, true>(lds, g, S, E); } SEAM(pb + 6 * half + 1); }
        if (half) break;
        if (EN(3) && IN(pb + 2)) { WSL; pg8::Gemm g{XB, (const bf16_t*)(wl + WO_IN), DM, DM, M, INP, DM}; pg8::EpiWin E{wsl, args.in[7] + l * 4};
            REP(3) { pg8::StaticOrder S; S.init(M, INP, G, bx); pg8::gemm_phase<pg8::EpiWin, true>(lds, g, S, E); } SEAM(pb + 2); }
        if (IN(pb + 3)) {
            if (EN(4)) { WSL; pg8::Gemm g{P + PC_CQ, (const bf16_t*)(wl + WO_UQ), PP, 512, M, 1536, 512}; pg8::EpiUq E{wsl}; REP(4) { pg8::StaticOrder S; S.init(M, 1536, G, bx); pg8::gemm_phase<pg8::EpiUq, true>(lds, g, S, E); } }
            if (EN(5)) { WSL; pg8::Gemm g{P + PC_CKV, (const bf16_t*)(wl + WO_UKV), PP, 512, M, 2048, 512}; pg8::EpiUkv E{wsl}; REP(5) { pg8::StaticOrder S; S.init(M, 2048, G, bx); pg8::gemm_phase<pg8::EpiUkv, true>(lds, g, S, E); } }
            if (EN(6)) REP(6) for (int it = vcu; it < 1024; it += G) { WSL;
                const int br = it >> 9, i2 = it & 511, bh = i2 >> 4, sub = i2 & 15; const int b = bh >> 2, h = bh & 3;
                const int d = br ? 16 : 4; const int res = br ? sub : (sub >> 2), qb = br ? 0 : (sub & 3);
                const size_t row0 = (size_t)b * SEQ + res;
                att::Blk B{}; B.qs = (long)PP * d; B.ks = B.qs; B.vs = B.qs; B.os = 512L * d; B.ls = 4L * d; B.P0 = qb * 256; B.W = 129;
                B.Q = P + (row0 + (size_t)qb * 256 * d) * PP + PC_DQ + h * HD; B.K = P + row0 * PP + PC_DK + h * HD; B.V = P + row0 * PP + PC_DV + h * HD;
                B.O = DILO + (size_t)br * M * 512 + (row0 + (size_t)qb * 256 * d) * 512 + h * HD; B.Lo = LSE + (size_t)br * M * 4 + (row0 + (size_t)qb * 256 * d) * 4 + h;
                att::attn_block<2>(B, lds);
            }
            SEAM(pb + 3);
        }
        if (IN(pb + 4)) {
            if (EN(7)) REP(7) for (int it = vcu; it < 256; it += G) { WSL; const int bh = it >> 3, x = it & 7, b = bh >> 2, h = bh & 3;
                att::fox_bias_table(LOGF, b, h, lds);
                for (int pass = 0; pass < 2; ++pass) { const int qb = pass ? 15 - x : x; const size_t row0 = (size_t)b * SEQ;
                    att::Blk B{}; B.qs = PP; B.ks = PP; B.vs = PP; B.os = 2048; B.P0 = qb * 256; B.W = 1 << 20;
                    B.Q = P + (row0 + (size_t)qb * 256) * PP + PC_FQ + h * HD; B.K = P + row0 * PP + PC_FK + h * HD; B.V = P + row0 * PP + PC_FV + h * HD;
                    B.O = MIX + (row0 + (size_t)qb * 256) * 2048 + h * HD;
                    att::attn_block<0>(B, lds); } }
            if (EN(8)) REP(8) for (int it = vcu; it < 512; it += G) { WSL; const int bh = it >> 3, x = it & 7, b = bh >> 3, h = bh & 7;
                for (int pass = 0; pass < 2; ++pass) { const int qb = pass ? 15 - x : x; const size_t row0 = (size_t)b * SEQ;
                    att::Blk B{}; B.qs = 1024; B.qrs = 512; B.ks = 2048; B.krs = 64; B.vs = 2048; B.os = 2048; B.P0 = qb * 256; B.W = 1 << 20;
                    B.Q = QBN + (row0 + (size_t)qb * 256) * 1024 + h * HD; B.Qr = QBR + (row0 + (size_t)qb * 256) * 512 + h * 64;
                    B.K = KVB + row0 * 2048 + h * 256; B.Kr = KR + row0 * 64; B.V = KVB + row0 * 2048 + h * 256 + HD;
                    B.O = MIX + (row0 + (size_t)qb * 256) * 2048 + 512 + h * HD;
                    att::attn_block<1>(B, lds); } }
            if (EN(9)) REP(9) for (int it = vcu; it < 512; it += G) { WSL; const int bh = it >> 4, qb = it & 15, b = bh >> 2, h = bh & 3; const size_t row0 = (size_t)b * SEQ, rq = row0 + (size_t)qb * 256;
                att::Blk B{}; B.qs = PP; B.ks = PP; B.vs = PP; B.os = 2048; B.P0 = qb * 256; B.W = 129;
                B.Q = P + rq * PP + PC_DQ + h * HD; B.K = P + row0 * PP + PC_DK + h * HD; B.V = P + row0 * PP + PC_DV + h * HD;
                B.O = MIX + rq * 2048 + 1536 + h * HD;
                B.O2 = DILO + rq * 512 + h * HD; B.O3 = DILO + (size_t)M * 512 + rq * 512 + h * HD; B.L2 = LSE + rq * 4 + h; B.L3 = LSE + (size_t)M * 4 + rq * 4 + h; B.o23s = 512; B.l23s = 4;
                att::attn_block<3>(B, lds); }
            SEAM(pb + 4);
        }
        if (EN(10) && IN(pb + 5)) { WSL; pg8::Gemm g{MIX, (const bf16_t*)(wl + WO_OUT), DM, DM, M, DM, DM}; REP(10) { pg8::StaticOrder S; S.init(M, DM, G, bx, 4); pg8::EpiResid E{XB, (rep + 1 < NREP(10)) ? (bf16_t*)(GAS bf16_t*)(wsl + WS_P) : XB, wsl, 1.0f}; pg8::gemm_phase<pg8::EpiResid, true>(lds, g, S, E); } SEAM(pb + 5); }
        }
    }
    if (EN(11) && IN(NPHASE - 1)) { WSL; SITE_LANE;
        const float* gf = args.in[17];
        for (int m = gw; m < M; m += NGW) { float s = (lane < 32) ? SSQ[(size_t)m * 32 + lane] : 0.f;
#pragma unroll
            for (int o = 1; o < 64; o <<= 1) s += __shfl_xor(s, o);
            const float r = __builtin_amdgcn_rsqf(s * (1.0f / DM) + EPS);
            const u32x4* xr = (const u32x4*)(XB + (size_t)m * DM) + lane; f32x4* orow = (f32x4*)(xres + (size_t)m * DM); const f32x4* gr = (const f32x4*)gf;
#pragma unroll
            for (int j = 0; j < 4; ++j) { const u32x4 b = xr[64 * j]; const int c = (64 * j + lane) * 2;
                f32x4 v0, v1; v0[0] = __uint_as_float(b.x << 16); v0[1] = __uint_as_float(b.x & 0xffff0000u); v0[2] = __uint_as_float(b.y << 16); v0[3] = __uint_as_float(b.y & 0xffff0000u);
                v1[0] = __uint_as_float(b.z << 16); v1[1] = __uint_as_float(b.z & 0xffff0000u); v1[2] = __uint_as_float(b.w << 16); v1[3] = __uint_as_float(b.w & 0xffff0000u);
                orow[c] = v0 * r * gr[c]; orow[c + 1] = v1 * r * gr[c + 1]; } }
    }
#undef IN
#undef SEAM
#undef EN
}

#ifndef MK_ONE_LAUNCH
#define MK_ONE_LAUNCH 1
#endif
extern "C" void kernel_launch(void* const* d_in, const int* in_sizes, int n_in, void* d_out, int out_size, void* d_ws, size_t ws_size, hipStream_t stream) {
    static int grid = 0;
    if (grid == 0) {
        if (n_in != 18 || in_sizes[0] != M * DM || out_size != M * DM || ws_size < WS_END) {
            fprintf(stderr, "kernel_launch: shape/workspace mismatch (n_in %d, in0 %d, out %d, ws %zu, need %zu)\n", n_in, n_in > 0 ? in_sizes[0] : -1, out_size, ws_size, (size_t)WS_END); grid = -1; return; }
        int dev = 0, cus = 0;
        if (hipGetDevice(&dev) != hipSuccess || hipDeviceGetAttribute(&cus, hipDeviceAttributeMultiprocessorCount, dev) != hipSuccess) { grid = -1; return; }
        if (hipFuncSetAttribute((const void*)mk_fwd, hipFuncAttributeMaxDynamicSharedMemorySize, LDS_BYTES) != hipSuccess) { fprintf(stderr, "kernel_launch: hipFuncSetAttribute failed\n"); grid = -1; return; }
        int per_cu = 0;
        if (hipOccupancyMaxActiveBlocksPerMultiprocessor(&per_cu, (const void*)mk_fwd, NWAVES * 64, LDS_BYTES) != hipSuccess || per_cu < 1) fprintf(stderr, "kernel_launch: occupancy query says %d\n", per_cu);
        (void)hipGetLastError();
        grid = cus;
    }
    if (grid < 0) return;
    if (hipMemsetAsync((char*)d_ws + WS_CTL, 0, CTL_ZERO_BYTES, stream) != hipSuccess) return;
    Args a{};
    for (int i = 0; i < 18; ++i) a.in[i] = (const float*)d_in[i];
    a.out = (float*)d_out; a.ws = (unsigned char*)d_ws;
#if MK_ONE_LAUNCH
    a.ph_lo = 0; a.ph_hi = NPHASE; a.use_bar = 1;
    hipLaunchKernelGGL(mk_fwd, dim3(grid), dim3(NWAVES * 64), LDS_BYTES, stream, a);
#else
    for (int p = 0; p < NPHASE; ++p) { a.ph_lo = p; a.ph_hi = p + 1; a.use_bar = 0;
        hipLaunchKernelGGL(mk_fwd, dim3(grid), dim3(NWAVES * 64), LDS_BYTES, stream, a); }
#endif
}
```

```cpp
#include <hip/hip_runtime.h>
#include <cstdio>
#include <cstdint>

#ifndef MK_EPI_REP
#define MK_EPI_REP 1
#endif
#define LAS __attribute__((address_space(3)))
#define GAS __attribute__((address_space(1)))
typedef unsigned short bf16_t;
typedef short bf16x8 __attribute__((ext_vector_type(8)));
typedef short s16x4 __attribute__((ext_vector_type(4)));
typedef float f32x4 __attribute__((ext_vector_type(4)));
typedef float f32x2 __attribute__((ext_vector_type(2)));
typedef float f32x16 __attribute__((ext_vector_type(16)));
typedef unsigned u32x4 __attribute__((ext_vector_type(4)));
typedef unsigned u32x2 __attribute__((ext_vector_type(2)));

constexpr int BATCH = 8, SEQ = 4096, DM = 2048, DEPTH = 4, FF = 5632, HD = 128;
constexpr int M = BATCH * SEQ;
constexpr int IN_W = 4164, INP = 4352;
constexpr int NGU = 2 * FF;
constexpr float EPS = 1e-6f;
constexpr float LOG2E = 1.4426950408889634f;
constexpr float C2_FOX = 0.08838834764831845f * LOG2E;
constexpr float C2_DIL = C2_FOX;
constexpr float C2_MLA = 0.07216878364870322f * LOG2E;
constexpr int PP = 4096;
constexpr int PC_FQ = 0, PC_FK = 512, PC_FV = 1024, PC_CQ = 1536, PC_CKV = 2048, PC_DQ = 2560, PC_DK = 3072, PC_DV = 3584;

constexpr size_t MiB = 1u << 20;
constexpr size_t WS_CTL = 0, CTL_ZERO_BYTES = 1 * MiB;
constexpr size_t WS_COSM = 1 * MiB;
constexpr size_t WS_SINM = WS_COSM + 512 * 1024;
constexpr size_t WS_COSP = 2 * MiB;
constexpr size_t WS_SINP = WS_COSP + 256 * 1024;
constexpr size_t WS_SSQ = 4 * MiB;
constexpr size_t WS_SSQQ = 8 * MiB;
constexpr size_t WS_SSQKV = 9 * MiB;
constexpr size_t WS_LOGF = 10 * MiB;
constexpr size_t WS_LSE = 11 * MiB;
constexpr size_t WS_W = 16 * MiB;
constexpr size_t W_GU = (size_t)NGU * DM * 2, W_DN = (size_t)DM * FF * 2, W_IN = (size_t)INP * DM * 2, W_UQ = (size_t)1536 * 512 * 2, W_UKV = (size_t)2048 * 512 * 2, W_OUT = (size_t)DM * DM * 2;
constexpr size_t WO_GU1 = 0, WO_DN1 = WO_GU1 + W_GU, WO_IN = WO_DN1 + W_DN, WO_UQ = WO_IN + W_IN, WO_UKV = WO_UQ + W_UQ, WO_OUT = WO_UKV + W_UKV, WO_GU2 = WO_OUT + W_OUT, WO_DN2 = WO_GU2 + W_GU, W_LAYER = WO_DN2 + W_DN;
constexpr size_t WS_XB = WS_W + DEPTH * W_LAYER;
constexpr size_t WS_BIG = WS_XB + (size_t)M * DM * 2;
constexpr size_t WS_P = WS_BIG;
constexpr size_t WS_KR = WS_P + (size_t)M * PP * 2;
constexpr size_t WS_QBN = WS_KR + (size_t)M * 64 * 2;
constexpr size_t WS_QBR = WS_QBN + (size_t)M * 1024 * 2;
constexpr size_t WS_KVB = WS_QBR + (size_t)M * 512 * 2;
constexpr size_t WS_MIX = WS_KVB + (size_t)M * 2048 * 2;
constexpr size_t WS_DILO = WS_MIX + (size_t)M * 2048 * 2;
constexpr size_t WS_END = WS_DILO + (size_t)2 * M * 512 * 2;
static_assert(W_LAYER % 256 == 0 && WS_BIG + (size_t)M * FF * 2 <= WS_END, "ws map");

constexpr int CW_BAR = 4096;

__device__ __forceinline__ unsigned cvt_pk_bf16(float lo, float hi) { unsigned r; asm volatile("v_cvt_pk_bf16_f32 %0, %1, %2" : "=v"(r) : "v"(lo), "v"(hi)); return r; }
__device__ __forceinline__ float bf2f(unsigned short h) { return __uint_as_float((unsigned)h << 16); }
#define LDS_WAIT() asm volatile("s_waitcnt lgkmcnt(0)" ::: "memory")
#define VM_WAIT() asm volatile("s_waitcnt vmcnt(0)" ::: "memory")

namespace pg8 {
constexpr int BM = 256, BK = 64, HALF = 128, HTB = HALF * BK * 2, STAGE_BYTES = 8 * HTB, NXCD = 8, WGM = 8;
__host__ __device__ __forceinline__ int lds_byte(int r, int c) { const int st = (r >> 4) * 2 + (c >> 5), rr = r & 15, cc = c & 31, ob = rr * 64 + cc * 2; return st * 1024 + (ob ^ (((ob >> 9) & 1) << 5)); }
__host__ __device__ __forceinline__ void stage_rc(int b, int& R, int& C) { const int st = b / 1024, sb = b % 1024, swz = sb ^ (((sb >> 9) & 1) << 5); R = (st >> 1) * 16 + swz / 64; C = (st & 1) * 32 + (swz % 64) / 2; }
__host__ __device__ __forceinline__ int perm32(int rho) { const int n = rho >> 4, i = rho & 15; return 8 * (i >> 2) + 4 * n + (i & 3); }
struct Unit { int pm, pn; };
struct Gemm { const bf16_t* A; const bf16_t* Bt; int lda, ldb, M, N, K; int kstepA = BK * 2, tstepA = 0; };
struct StaticOrder {
    int nM, nN, nwg, G, c, wgm;
    __host__ __device__ void init(int M_, int N_, int G_, int c_, int wgm_ = WGM) { nM = M_ / BM; nN = N_ / BM; nwg = nM * nN; G = G_; c = c_; wgm = wgm_; }
    __host__ __device__ bool next(int i, Unit& u) const {
        const long L = (long)i * G + c; if (L >= nwg) return false;
        int wgid = (int)L; { const int q = nwg / NXCD, r = nwg % NXCD, xcd = wgid % NXCD, off = wgid / NXCD; wgid = (xcd < r ? xcd * (q + 1) : r * (q + 1) + (xcd - r) * q) + off; }
        const int nig = wgm * nN, gid = wgid / nig, fm = gid * wgm, gsz = (nM - fm) < wgm ? (nM - fm) : wgm;
        u.pm = fm + ((wgid % nig) % gsz); u.pn = (wgid % nig) / gsz; return true;
    }
};
template <class Epi, bool ALIGN_EPI>
__device__ __forceinline__ void gemm_phase(LAS unsigned char* lds, const Gemm g, const StaticOrder& S, const Epi& E) {
    int tid_o = threadIdx.x; asm volatile("" : "+v"(tid_o));
    const int tid = tid_o, wid = __builtin_amdgcn_readfirstlane(tid >> 6), lane = tid & 63, wr = wid >> 2, wc = wid & 3, fr = lane & 15, fq = lane >> 4;
    const int K = g.K, nt = K / BK;
    unsigned voffA[2], voffB[2];
#pragma unroll
    for (int i = 0; i < 2; ++i) { int R, C; stage_rc(tid * 16 + i * 8192, R, C); const int Rb = Epi::PERM ? ((R & ~31) + perm32(R & 31)) : R;
        voffA[i] = (unsigned)(R * g.lda + C) * 2u; voffB[i] = (unsigned)(Rb * g.ldb + C) * 2u; }
    const size_t kstep = (size_t)(BK * 2), kstepA = (size_t)g.kstepA;
    const size_t hstepA = (size_t)HALF * g.lda * 2, hstepB = (size_t)HALF * g.ldb * 2;
    const size_t tstepA = g.tstepA ? (size_t)g.tstepA : 2 * hstepA, tstepB = 2 * hstepB;
    const unsigned ldsw = (unsigned)wid * 1024u;
    const __amdgpu_buffer_rsrc_t srdA = __builtin_amdgcn_make_buffer_rsrc((void*)g.A, (short)0, 0x7fffffff, 0x00020000), srdB = __builtin_amdgcn_make_buffer_rsrc((void*)g.Bt, (short)0, 0x7fffffff, 0x00020000);
    const int aoff = lds_byte(wr * 64 + fr, fq * 8), boff = lds_byte(wc * 32 + fr, fq * 8);
#define PG8_SA(b, h) (((b) * 2 + (h)) * HTB)
#define PG8_SB(b, h) ((4 + (b) * 2 + (h)) * HTB)
#define PG8_STAGE(srd, base0, bufoff, gbase, voff) do { const unsigned so_ = (unsigned)((const char*)(gbase) - (const char*)(base0)); _Pragma("unroll") for (int _i = 0; _i < 2; ++_i) \
        __builtin_amdgcn_raw_ptr_buffer_load_lds(srd, (LAS void*)(lds + (bufoff) + ldsw + _i * 8192), 16, (int)(voff)[_i], (int)so_, 0, 0); } while (0)
#define PG8_LDA(dst, b, h) do { _Pragma("unroll") for (int m = 0; m < 4; ++m) _Pragma("unroll") for (int k = 0; k < 2; ++k) dst[m][k] = *(const LAS bf16x8*)(lds + PG8_SA(b, h) + aoff + m * 2048 + k * 1024); } while (0)
#define PG8_LDB(dst, b, h) do { _Pragma("unroll") for (int n = 0; n < 2; ++n) _Pragma("unroll") for (int k = 0; k < 2; ++k) dst[n][k] = *(const LAS bf16x8*)(lds + PG8_SB(b, h) + boff + n * 2048 + k * 1024); } while (0)
#define PG8_MMA(ai, bj, At, Bt) do { __builtin_amdgcn_s_setprio(1); _Pragma("unroll") for (int m = 0; m < 4; ++m) _Pragma("unroll") for (int n = 0; n < 2; ++n) _Pragma("unroll") for (int k = 0; k < 2; ++k) \
        acc[ai][bj][m][n] = __builtin_amdgcn_mfma_f32_16x16x32_bf16(Bt[n][k], At[m][k], acc[ai][bj][m][n], 0, 0, 0); __builtin_amdgcn_s_setprio(0); } while (0)
#define PG8_WAIT_V(n) asm volatile("s_waitcnt vmcnt(" #n ")" ::: "memory")
#define PG8_WAIT_L(n) asm volatile("s_waitcnt lgkmcnt(" #n ")" ::: "memory")
#define PG8_BAR __builtin_amdgcn_s_barrier()
#define PG8_SCHED __builtin_amdgcn_sched_barrier(0)
    Unit cur, nxt; int ui = 0;
    if (!S.next(0, cur)) return;
    __builtin_amdgcn_s_waitcnt(0x0F70);
    LAS float* rc = (LAS float*)(lds + STAGE_BYTES + 1024) + wid * 144;
    *(volatile LAS int*)(rc + 128) = -1;
    f32x4 acc[2][2][4][2];
#pragma unroll
    for (int a = 0; a < 2; ++a)
#pragma unroll
        for (int b = 0; b < 2; ++b)
#pragma unroll
            for (int m = 0; m < 4; ++m)
#pragma unroll
                for (int n = 0; n < 2; ++n) acc[a][b][m][n] = (f32x4){0.f, 0.f, 0.f, 0.f};
    bf16x8 At[4][2], B0[2][2], B1[2][2];
    const char* cA = (const char*)g.A + (size_t)cur.pm * tstepA; const char* cB = (const char*)g.Bt + (size_t)cur.pn * tstepB;
    PG8_STAGE(srdB, g.Bt, PG8_SB(0, 0), cB, voffB); PG8_STAGE(srdB, g.Bt, PG8_SB(0, 1), cB + hstepB, voffB); PG8_STAGE(srdA, g.A, PG8_SA(0, 0), cA, voffA); PG8_STAGE(srdA, g.A, PG8_SA(0, 1), cA + hstepA, voffA);
    if (wr == 1) PG8_BAR;
    PG8_WAIT_V(2); PG8_BAR;
    PG8_STAGE(srdB, g.Bt, PG8_SB(1, 0), cB + kstep, voffB); PG8_STAGE(srdA, g.A, PG8_SA(1, 0), cA + kstepA, voffA); PG8_STAGE(srdB, g.Bt, PG8_SB(1, 1), cB + hstepB + kstep, voffB);
    PG8_WAIT_V(6); PG8_BAR;
    for (;;) {
        const bool has_next = S.next(ui + 1, nxt);
        const char* nA = has_next ? (const char*)g.A + (size_t)nxt.pm * tstepA : cA; const char* nB = has_next ? (const char*)g.Bt + (size_t)nxt.pn * tstepB : cB;
        for (int t = 0; t < nt; t += 2) {
            const bool last = (t == nt - 2);
            const char* a1 = cA + (size_t)(t + 1) * kstepA;
            const char* a2 = last ? nA : cA + (size_t)(t + 2) * kstepA; const char* b2 = last ? nB : cB + (size_t)(t + 2) * kstep;
            const char* a3 = a2 + kstepA; const char* b3 = b2 + kstep;
            PG8_LDB(B0, 0, 0); PG8_LDB(B1, 0, 1); PG8_SCHED; PG8_LDA(At, 0, 0); PG8_STAGE(srdA, g.A, PG8_SA(1, 1), a1 + hstepA, voffA);
            PG8_WAIT_V(8); PG8_WAIT_L(0); PG8_BAR; PG8_MMA(0, 0, At, B0); PG8_MMA(0, 1, At, B1); PG8_BAR; PG8_SCHED;
            PG8_LDA(At, 0, 1); PG8_STAGE(srdB, g.Bt, PG8_SB(0, 0), b2, voffB); PG8_STAGE(srdB, g.Bt, PG8_SB(0, 1), b2 + hstepB, voffB); PG8_STAGE(srdA, g.A, PG8_SA(0, 0), a2, voffA);
            PG8_WAIT_V(8); PG8_WAIT_L(0); PG8_BAR; PG8_MMA(1, 0, At, B0); PG8_MMA(1, 1, At, B1); PG8_BAR; PG8_SCHED;
            PG8_LDB(B0, 1, 0); PG8_LDB(B1, 1, 1); PG8_SCHED; PG8_LDA(At, 1, 0); PG8_STAGE(srdA, g.A, PG8_SA(0, 1), a2 + hstepA, voffA);
            PG8_WAIT_V(8); PG8_WAIT_L(0); PG8_BAR; PG8_MMA(0, 0, At, B0); PG8_MMA(0, 1, At, B1); PG8_BAR; PG8_SCHED;
            PG8_LDA(At, 1, 1); PG8_STAGE(srdB, g.Bt, PG8_SB(1, 0), b3, voffB); PG8_STAGE(srdB, g.Bt, PG8_SB(1, 1), b3 + hstepB, voffB); PG8_STAGE(srdA, g.A, PG8_SA(1, 0), a3, voffA);
            PG8_WAIT_V(8); PG8_WAIT_L(0); PG8_BAR; PG8_MMA(1, 0, At, B0); PG8_MMA(1, 1, At, B1); PG8_BAR; PG8_SCHED;
        }
        if constexpr (ALIGN_EPI) { if (wr == 0) PG8_BAR; }
        E(acc, cur, wr, wc, fr, fq, rc);
        if constexpr (Epi::EREP > 1) { for (int er_ = 1; er_ < Epi::EREP; ++er_) { asm volatile("" ::: "memory"); E(acc, cur, wr, wc, fr, fq, rc); } }
        if (!has_next) break;
#pragma unroll
        for (int a = 0; a < 2; ++a)
#pragma unroll
            for (int b = 0; b < 2; ++b)
#pragma unroll
                for (int m = 0; m < 4; ++m)
#pragma unroll
                    for (int n = 0; n < 2; ++n) acc[a][b][m][n] = (f32x4){0.f, 0.f, 0.f, 0.f};
        cur = nxt; cA = nA; cB = nB; ++ui;
        if constexpr (ALIGN_EPI) { if (wr == 1) PG8_BAR; }
    }
    PG8_WAIT_V(0);
    if constexpr (!ALIGN_EPI) { if (wr == 0) PG8_BAR; }
    PG8_BAR;
#undef PG8_SA
#undef PG8_SB
#undef PG8_STAGE
#undef PG8_LDA
#undef PG8_LDB
#undef PG8_MMA
#undef PG8_WAIT_V
#undef PG8_WAIT_L
#undef PG8_BAR
#undef PG8_SCHED
}

__device__ __forceinline__ float xrow16_sum(float x) {
    auto s = __builtin_amdgcn_permlane16_swap(__float_as_uint(x), __float_as_uint(x), false, false);
    x = __uint_as_float(s[0]) + __uint_as_float(s[1]);
    auto t = __builtin_amdgcn_permlane32_swap(__float_as_uint(x), __float_as_uint(x), false, false);
    return __uint_as_float(t[0]) + __uint_as_float(t[1]);
}
template <int NP> __device__ __forceinline__ void load_rstd(const float* ssq, int row0, int fq, float inv_n, float (&rs)[2][4]) {
    float sv[8];
    if constexpr (NP == 32) {
#pragma unroll
        for (int h = 0; h < 2; ++h) { f32x4 a[4], b[4];
#pragma unroll
            for (int i = 0; i < 4; ++i) { const float* p = ssq + (size_t)(row0 + h * HALF + i * 16) * 32 + 8 * fq; a[i] = *(const f32x4*)p; b[i] = *(const f32x4*)(p + 4); }
#pragma unroll
            for (int i = 0; i < 4; ++i) sv[4 * h + i] = ((a[i][0] + a[i][1]) + (a[i][2] + a[i][3])) + ((b[i][0] + b[i][1]) + (b[i][2] + b[i][3]));
            asm volatile("" ::: "memory"); }
    } else { f32x2 a[8];
#pragma unroll
        for (int i = 0; i < 8; ++i) a[i] = *(const f32x2*)(ssq + (size_t)(row0 + (i >> 2) * HALF + (i & 3) * 16) * 8 + 2 * fq);
#pragma unroll
        for (int i = 0; i < 8; ++i) sv[i] = a[i][0] + a[i][1];
    }
#pragma unroll
    for (int i = 0; i < 8; ++i) sv[i] = xrow16_sum(sv[i]);
#pragma unroll
    for (int i = 0; i < 8; ++i) rs[i >> 2][i & 3] = __builtin_amdgcn_rsqf(sv[i] * inv_n + EPS);
}
template <int NP> __device__ __forceinline__ void load_rstd_cached(const float* ssq, int row0, int fq, int fr, float inv_n, float (&rs)[2][4], LAS float* rc, int pm) {
    const int tag = __builtin_amdgcn_readfirstlane(*(volatile LAS int*)(rc + 128));
    if (tag == pm) {
#pragma unroll
        for (int i = 0; i < 8; ++i) rs[i >> 2][i & 3] = rc[i * 16 + fr];
    } else {
        load_rstd<NP>(ssq, row0, fq, inv_n, rs);
        if (fq == 0) {
#pragma unroll
            for (int i = 0; i < 8; ++i) rc[i * 16 + fr] = rs[i >> 2][i & 3]; }
        *(volatile LAS int*)(rc + 128) = pm;
    }
}
struct EpiGateUp {
    static constexpr bool PERM = true; static constexpr int EREP = MK_EPI_REP;
    GAS unsigned char* ws;
    __device__ __forceinline__ void operator()(const f32x4 (&acc)[2][2][4][2], const Unit& u, int wr, int wc, int fr, int fq, LAS float* rc) const {
        bf16_t* O = (bf16_t*)(GAS bf16_t*)(ws + WS_BIG); const float* ssq = (const float*)(GAS float*)(ws + WS_SSQ);
        const int row0 = u.pm * BM + wr * 64 + fr, col0 = u.pn * HALF + wc * 32 + 8 * fq;
        float rs[2][4]; load_rstd_cached<32>(ssq, row0, fq, fr, 1.0f / DM, rs, rc, u.pm);
#pragma unroll
        for (int ai = 0; ai < 2; ++ai)
#pragma unroll
            for (int m = 0; m < 4; ++m) { const float r = rs[ai][m], c1 = -r * LOG2E, R = __builtin_amdgcn_rcpf(r * r); f32x2 t[4], gu[4];
#pragma unroll
                for (int i = 0; i < 4; ++i) { const f32x2 g = {acc[ai][0][m][i >> 1][2 * (i & 1)], acc[ai][0][m][i >> 1][2 * (i & 1) + 1]}, uu = {acc[ai][1][m][i >> 1][2 * (i & 1)], acc[ai][1][m][i >> 1][2 * (i & 1) + 1]};
                    t[i] = g * c1; gu[i] = g * uu; }
#pragma unroll
                for (int i = 0; i < 4; ++i) { t[i].x = __builtin_amdgcn_exp2f(t[i].x); t[i].y = __builtin_amdgcn_exp2f(t[i].y); }
#pragma unroll
                for (int i = 0; i < 4; ++i) { t[i].x = __builtin_fmaf(t[i].x, R, R); t[i].y = __builtin_fmaf(t[i].y, R, R); }
#pragma unroll
                for (int i = 0; i < 4; ++i) { t[i].x = __builtin_amdgcn_rcpf(t[i].x); t[i].y = __builtin_amdgcn_rcpf(t[i].y); }
#pragma unroll
                for (int i = 0; i < 4; ++i) gu[i] = gu[i] * t[i];
                u32x4 w; w.x = cvt_pk_bf16(gu[0].x, gu[0].y); w.y = cvt_pk_bf16(gu[1].x, gu[1].y); w.z = cvt_pk_bf16(gu[2].x, gu[2].y); w.w = cvt_pk_bf16(gu[3].x, gu[3].y);
                { const int row = row0 + ai * HALF + m * 16;
                  *(u32x4*)(O + ((size_t)((row >> 8) * (FF / 64) + (col0 >> 6)) * 256 + (row & 255)) * 64 + (col0 & 63)) = w; } }
    }
};
struct EpiResid {
    static constexpr bool PERM = true; static constexpr int EREP = 1;
    const bf16_t* base; bf16_t* outb; GAS unsigned char* ws; float scale;
    __device__ __forceinline__ void operator()(const f32x4 (&acc)[2][2][4][2], const Unit& u, int wr, int wc, int fr, int fq, LAS float* rc) const {
        float* ssq = (float*)(GAS float*)(ws + WS_SSQ);
        const int row0 = u.pm * BM + wr * 64 + fr, col0 = u.pn * BM + wc * 32 + 8 * fq;
#pragma unroll
        for (int hb = 0; hb < 2; ++hb) {
        u32x4 pre[4][2];
#pragma unroll
        for (int g4 = 0; g4 < 4; ++g4) { const size_t off = (size_t)(row0 + hb * HALF + g4 * 16) * DM + col0;
            pre[g4][0] = __builtin_nontemporal_load((const u32x4*)(base + off)); pre[g4][1] = __builtin_nontemporal_load((const u32x4*)(base + off + HALF)); }
#pragma unroll
        for (int g4 = 0; g4 < 4; ++g4) { const int ai = hb, m = g4, row = row0 + ai * HALF + m * 16; const size_t off = (size_t)row * DM + col0; float sq = 0.f;
            f32x2 sq2 = {0.f, 0.f};
#pragma unroll
            for (int bj = 0; bj < 2; ++bj) { const u32x4 b = pre[g4][bj];
                f32x2 x0 = {__uint_as_float(b.x << 16), __uint_as_float(b.x & 0xffff0000u)}, x1 = {__uint_as_float(b.y << 16), __uint_as_float(b.y & 0xffff0000u)};
                f32x2 x2 = {__uint_as_float(b.z << 16), __uint_as_float(b.z & 0xffff0000u)}, x3 = {__uint_as_float(b.w << 16), __uint_as_float(b.w & 0xffff0000u)};
                const f32x4 a0 = acc[ai][bj][m][0], a1 = acc[ai][bj][m][1];
                x0 = x0 + (f32x2){a0[0], a0[1]} * scale; x1 = x1 + (f32x2){a0[2], a0[3]} * scale; x2 = x2 + (f32x2){a1[0], a1[1]} * scale; x3 = x3 + (f32x2){a1[2], a1[3]} * scale;
                u32x4 w; w.x = cvt_pk_bf16(x0.x, x0.y); w.y = cvt_pk_bf16(x1.x, x1.y); w.z = cvt_pk_bf16(x2.x, x2.y); w.w = cvt_pk_bf16(x3.x, x3.y);
                *(u32x4*)(outb + off + bj * HALF) = w;
                sq2 = sq2 + x0 * x0; sq2 = sq2 + x1 * x1; sq2 = sq2 + x2 * x2; sq2 = sq2 + x3 * x3; }
            sq = sq2.x + sq2.y;
            sq = xrow16_sum(sq); if (fq == 0) ssq[(size_t)row * 32 + u.pn * 4 + wc] = sq; }
        asm volatile("" ::: "memory"); }
    }
};
struct EpiWin {
    static constexpr bool PERM = false; static constexpr int EREP = 1;
    GAS unsigned char* ws; const float* fbias;
    __device__ __forceinline__ void operator()(const f32x4 (&acc)[2][2][4][2], const Unit& u, int wr, int wc, int fr, int fq, LAS float* rc) const {
        bf16_t* P = (bf16_t*)(GAS bf16_t*)(ws + WS_P); bf16_t* KR = (bf16_t*)(GAS bf16_t*)(ws + WS_KR); float* logf = (float*)(GAS float*)(ws + WS_LOGF); const float* ssq = (const float*)(GAS float*)(ws + WS_SSQ);
        float* ssqq = (float*)(GAS float*)(ws + WS_SSQQ); float* ssqkv = (float*)(GAS float*)(ws + WS_SSQKV);
        const float* cosp = (const float*)(GAS float*)(ws + WS_COSP); const float* sinp = (const float*)(GAS float*)(ws + WS_SINP); const float* cosm = (const float*)(GAS float*)(ws + WS_COSM); const float* sinm = (const float*)(GAS float*)(ws + WS_SINM);
        const int row0 = u.pm * BM + wr * 64 + fr;
        float rs[2][4]; load_rstd_cached<32>(ssq, row0, fq, fr, 1.0f / DM, rs, rc, u.pm);
        const int pn = u.pn, grp = pn >> 1;
        if (pn < 16) {
            const float sc = (grp == 0) ? C2_FOX : (grp == 5) ? C2_DIL : 1.0f;
            const bool rope = (grp == 5 || grp == 6) && wc == 0;
            float* sq_dst = (grp == 3) ? ssqq : (grp == 4) ? ssqkv : nullptr;
#pragma unroll
            for (int ai = 0; ai < 2; ++ai)
#pragma unroll
                for (int m = 0; m < 4; ++m) { const int row = row0 + ai * HALF + m * 16; const float r = rs[ai][m]; const int s = row & (SEQ - 1); float sq = 0.f;
#pragma unroll
                    for (int bj = 0; bj < 2; ++bj) { f32x4 v0 = acc[ai][bj][m][0] * r, v1 = acc[ai][bj][m][1] * r;
                        sq += (v0[0] * v0[0] + v0[1] * v0[1]) + (v0[2] * v0[2] + v0[3] * v0[3]) + (v1[0] * v1[0] + v1[1] * v1[1]) + (v1[2] * v1[2] + v1[3] * v1[3]);
                        if (rope) { const f32x4 c = *(const f32x4*)(cosp + s * 16 + 4 * fq), sn = *(const f32x4*)(sinp + s * 16 + 4 * fq);
                            const f32x4 a = v0 * c - v1 * sn, b = v0 * sn + v1 * c; v0 = a; v1 = b; }
                        v0 = v0 * sc; v1 = v1 * sc;
                        bf16_t* p = P + (size_t)row * PP + pn * BM + bj * HALF + wc * 32 + 4 * fq;
                        u32x2 w0, w1; w0.x = cvt_pk_bf16(v0[0], v0[1]); w0.y = cvt_pk_bf16(v0[2], v0[3]); w1.x = cvt_pk_bf16(v1[0], v1[1]); w1.y = cvt_pk_bf16(v1[2], v1[3]);
                        *(u32x2*)p = w0; *(u32x2*)(p + 16) = w1; }
                    if (sq_dst) { sq = xrow16_sum(sq); if (fq == 0) sq_dst[(size_t)row * 8 + (pn & 1) * 4 + wc] = sq; } }
        } else {
            if (wc < 2) {
#pragma unroll
                for (int ai = 0; ai < 2; ++ai)
#pragma unroll
                    for (int m = 0; m < 4; ++m) { const int row = row0 + ai * HALF + m * 16; const float r = rs[ai][m]; const int s = row & (SEQ - 1); const int d = 16 * wc + 4 * fq;
                        const f32x4 x1 = acc[ai][0][m][0] * r, x2 = acc[ai][0][m][1] * r;
                        const f32x4 c = *(const f32x4*)(cosm + s * 32 + d), sn = *(const f32x4*)(sinm + s * 32 + d);
                        const f32x4 a = x1 * c - x2 * sn, b = x1 * sn + x2 * c;
                        u32x2 w0, w1; w0.x = cvt_pk_bf16(a[0], a[1]); w0.y = cvt_pk_bf16(a[2], a[3]); w1.x = cvt_pk_bf16(b[0], b[1]); w1.y = cvt_pk_bf16(b[2], b[3]);
                        *(u32x2*)(KR + (size_t)row * 64 + d) = w0; *(u32x2*)(KR + (size_t)row * 64 + d + 32) = w1; }
            } else if (wc == 2 && fq == 0) {
                const f32x4 fb = *(const f32x4*)fbias;
#pragma unroll
                for (int ai = 0; ai < 2; ++ai)
#pragma unroll
                    for (int m = 0; m < 4; ++m) { const int row = row0 + ai * HALF + m * 16; const f32x4 z = acc[ai][0][m][0] * rs[ai][m] + fb; f32x4 o;
#pragma unroll
                        for (int j = 0; j < 4; ++j) { const float az = fabsf(z[j]); o[j] = fminf(z[j], 0.f) - log1pf(__expf(-az)); }
                        *(f32x4*)(logf + (size_t)row * 4) = o; }
            }
        }
    }
};
struct EpiUq {
    static constexpr bool PERM = false; static constexpr int EREP = 1;
    GAS unsigned char* ws;
    __device__ __forceinline__ void operator()(const f32x4 (&acc)[2][2][4][2], const Unit& u, int wr, int wc, int fr, int fq, LAS float* rc) const {
        bf16_t* QBn = (bf16_t*)(GAS bf16_t*)(ws + WS_QBN); bf16_t* QBr = (bf16_t*)(GAS bf16_t*)(ws + WS_QBR); const float* ssqq = (const float*)(GAS float*)(ws + WS_SSQQ);
        const float* cosm = (const float*)(GAS float*)(ws + WS_COSM); const float* sinm = (const float*)(GAS float*)(ws + WS_SINM);
        const int row0 = u.pm * BM + wr * 64 + fr;
        float rs[2][4]; load_rstd<8>(ssqq, row0, fq, 1.0f / 512, rs);
        const int pn = u.pn;
#pragma unroll
        for (int ai = 0; ai < 2; ++ai)
#pragma unroll
            for (int m = 0; m < 4; ++m) { const int row = row0 + ai * HALF + m * 16; const float r = rs[ai][m] * C2_MLA; const int s = row & (SEQ - 1);
#pragma unroll
                for (int bj = 0; bj < 2; ++bj) { const f32x4 v0 = acc[ai][bj][m][0] * r, v1 = acc[ai][bj][m][1] * r;
                    if (pn < 4) { bf16_t* p = QBn + (size_t)row * 1024 + pn * BM + bj * HALF + wc * 32 + 4 * fq;
                        u32x2 w0, w1; w0.x = cvt_pk_bf16(v0[0], v0[1]); w0.y = cvt_pk_bf16(v0[2], v0[3]); w1.x = cvt_pk_bf16(v1[0], v1[1]); w1.y = cvt_pk_bf16(v1[2], v1[3]);
                        *(u32x2*)p = w0; *(u32x2*)(p + 16) = w1; }
                    else { const int head = (pn - 4) * 4 + 2 * bj + (wc >> 1), d = 16 * (wc & 1) + 4 * fq;
                        const f32x4 c = *(const f32x4*)(cosm + s * 32 + d), sn = *(const f32x4*)(sinm + s * 32 + d);
                        const f32x4 a = v0 * c - v1 * sn, b = v0 * sn + v1 * c;
                        u32x2 w0, w1; w0.x = cvt_pk_bf16(a[0], a[1]); w0.y = cvt_pk_bf16(a[2], a[3]); w1.x = cvt_pk_bf16(b[0], b[1]); w1.y = cvt_pk_bf16(b[2], b[3]);
                        bf16_t* p = QBr + (size_t)row * 512 + head * 64 + d; *(u32x2*)p = w0; *(u32x2*)(p + 32) = w1; } } }
    }
};
struct EpiUkv {
    static constexpr bool PERM = true; static constexpr int EREP = 1;
    GAS unsigned char* ws;
    __device__ __forceinline__ void operator()(const f32x4 (&acc)[2][2][4][2], const Unit& u, int wr, int wc, int fr, int fq, LAS float* rc) const {
        bf16_t* KVB = (bf16_t*)(GAS bf16_t*)(ws + WS_KVB); const float* ssqkv = (const float*)(GAS float*)(ws + WS_SSQKV);
        const int row0 = u.pm * BM + wr * 64 + fr, col0 = u.pn * BM + wc * 32 + 8 * fq;
        float rs[2][4]; load_rstd<8>(ssqkv, row0, fq, 1.0f / 512, rs);
#pragma unroll
        for (int ai = 0; ai < 2; ++ai)
#pragma unroll
            for (int m = 0; m < 4; ++m) { const float r = rs[ai][m]; bf16_t* rowp = KVB + (size_t)(row0 + ai * HALF + m * 16) * 2048 + col0;
#pragma unroll
                for (int bj = 0; bj < 2; ++bj) { const f32x4 v0 = acc[ai][bj][m][0] * r, v1 = acc[ai][bj][m][1] * r;
                    u32x4 w; w.x = cvt_pk_bf16(v0[0], v0[1]); w.y = cvt_pk_bf16(v0[2], v0[3]); w.z = cvt_pk_bf16(v1[0], v1[1]); w.w = cvt_pk_bf16(v1[2], v1[3]);
                    *(u32x4*)(rowp + bj * HALF) = w; } }
    }
};
}

namespace att {
#define SBAR() __builtin_amdgcn_sched_barrier(0)
constexpr int SHM = 16384, SHMR = 8192;
constexpr int SHMV = SHM;
constexpr int OFF_V = 0, OFF_K = 3 * SHMV, OFF_KR = OFF_K + 3 * SHM, OFF_CUM = OFF_KR, ATT_LDS = OFF_KR + 3 * SHMR, OFF_WS = 131072 + 8192;
constexpr float THR2 = 24.0f;
static_assert(ATT_LDS <= 131072, "attention LDS");
__device__ __forceinline__ int kswz(int row, int colB) { return row * 256 + (colB ^ ((row & 15) << 4)); }
__device__ __forceinline__ int krswz(int row, int chunk) { return row * 128 + ((chunk ^ ((row >> 1) & 7)) << 4); }
typedef short v4i16_t __attribute__((ext_vector_type(4)));
__device__ __forceinline__ s16x4 vtr(const LAS unsigned char* p) { return __builtin_bit_cast(s16x4, __builtin_amdgcn_ds_read_tr16_b64_v4i16((LAS v4i16_t*)p)); }
__device__ __forceinline__ float xrow16_max(float x) {
    auto s = __builtin_amdgcn_permlane16_swap(__float_as_uint(x), __float_as_uint(x), false, false);
    x = fmaxf(__uint_as_float(s[0]), __uint_as_float(s[1]));
    auto t = __builtin_amdgcn_permlane32_swap(__float_as_uint(x), __float_as_uint(x), false, false);
    return fmaxf(__uint_as_float(t[0]), __uint_as_float(t[1]));
}
template <int OFF> __device__ __forceinline__ s16x4 vtra(unsigned a) { s16x4 r; asm volatile("ds_read_b64_tr_b16 %0, %1 offset:%2" : "=v"(r) : "v"(a), "n"(OFF) : "memory"); return r; }
__device__ __forceinline__ f32x4 mf16(bf16x8 a, bf16x8 b, f32x4 c) { return __builtin_amdgcn_mfma_f32_16x16x32_bf16(a, b, c, 0, 0, 0); }

struct Blk {
    const bf16_t* Q; long qs;
    const bf16_t* Qr; long qrs;
    const bf16_t* K; long ks;
    const bf16_t* Kr; long krs;
    const bf16_t* V; long vs;
    bf16_t* O; long os;
    float* Lo; long ls;
    const bf16_t* O2; const bf16_t* O3; const float* L2; const float* L3; long o23s; long l23s;
    int P0; int W;
};
template <int MODE>
__device__ __forceinline__ void attn_block(const Blk& B, LAS unsigned char* lds) {
    int tid_o = threadIdx.x; asm volatile("" : "+v"(tid_o));
    const int tid = tid_o, wid = __builtin_amdgcn_readfirstlane(tid >> 6), lane = tid & 63, fr = lane & 15, fq = lane >> 4;
    LAS unsigned char* V_lds = lds + OFF_V; LAS unsigned char* K_lds = lds + OFF_K; LAS unsigned char* KR_lds = lds + OFF_KR;
    const LAS float* biasL = (const LAS float*)(lds + OFF_CUM);
    bf16x8 qf[2][4]; bf16x8 qrf[2][2];
#pragma unroll
    for (int c = 0; c < 2; ++c) { const bf16_t* qp = B.Q + (long)(wid * 32 + 16 * c + fr) * B.qs + fq * 8;
#pragma unroll
        for (int s_ = 0; s_ < 4; ++s_) qf[c][s_] = *(const bf16x8*)(qp + 32 * s_);
        if constexpr (MODE == 1) { const bf16_t* qp2 = B.Qr + (long)(wid * 32 + 16 * c + fr) * B.qrs + fq * 8;
#pragma unroll
            for (int s_ = 0; s_ < 2; ++s_) qrf[c][s_] = *(const bf16x8*)(qp2 + 32 * s_); } }
    const int W = B.W, P0 = B.P0;
    const int lowk = P0 - W + 1; const int j_lo = lowk > 0 ? lowk / 64 : 0; const int j_hi = (P0 + 255) / 64 + 1;
    const int qpos0 = P0 + wid * 32 + fr;
    float m0 = -1e30f, m1 = -1e30f, l0 = 0.f, l1 = 0.f;
    f32x4 oacc[8][2];
#pragma unroll
    for (int d = 0; d < 8; ++d) { oacc[d][0] = f32x4{0.f, 0.f, 0.f, 0.f}; oacc[d][1] = f32x4{0.f, 0.f, 0.f, 0.f}; }
    const int dr = 8 * wid + (lane >> 4);
    const int kof0 = ((lane & 15) ^ (dr & 15)) * 8, kof1 = ((lane & 15) ^ ((dr + 4) & 15)) * 8;
    const int vof0 = ((((lane & 15) >> 1) ^ (dr & 7)) * 16) + (lane & 1) * 8, vof1 = ((((lane & 15) >> 1) ^ ((dr + 4) & 7)) * 16) + (lane & 1) * 8;
    const int rr = 8 * wid + (lane >> 3); const int rof = ((lane & 7) ^ ((rr >> 1) & 7)) * 8;
    constexpr int NDMA = (MODE == 1) ? 5 : 4;
    const __amdgpu_buffer_rsrc_t srK = __builtin_amdgcn_make_buffer_rsrc((void*)B.K, (short)0, 0x7fffffff, 0x00020000), srV = __builtin_amdgcn_make_buffer_rsrc((void*)B.V, (short)0, 0x7fffffff, 0x00020000);
    const __amdgpu_buffer_rsrc_t srR = __builtin_amdgcn_make_buffer_rsrc((void*)(MODE == 1 ? B.Kr : B.K), (short)0, 0x7fffffff, 0x00020000);
    const int ko0 = (int)((dr * B.ks + kof0) * 2), ko1 = (int)(((dr + 4) * B.ks + kof1) * 2), vo0 = (int)((dr * B.vs + vof0) * 2), vo1 = (int)(((dr + 4) * B.vs + vof1) * 2), ro0 = (int)((rr * B.krs + rof) * 2);
    const int kts = (int)(B.ks * 128), vts = (int)(B.vs * 128), rts = (int)(B.krs * 128);
#define T_DMA_K(t_, b_) do { const int so_ = (t_) * kts; \
        __builtin_amdgcn_raw_ptr_buffer_load_lds(srK, (LAS void*)(K_lds + (b_) * SHM + wid * 2048), 16, ko0, so_, 0, 0); \
        __builtin_amdgcn_raw_ptr_buffer_load_lds(srK, (LAS void*)(K_lds + (b_) * SHM + wid * 2048 + 1024), 16, ko1, so_, 0, 0); } while (0)
#define T_DMA_V(t_, b_) do { const int so_ = (t_) * vts; \
        __builtin_amdgcn_raw_ptr_buffer_load_lds(srV, (LAS void*)(V_lds + (b_) * SHMV + wid * 2048), 16, vo0, so_, 0, 0); \
        __builtin_amdgcn_raw_ptr_buffer_load_lds(srV, (LAS void*)(V_lds + (b_) * SHMV + wid * 2048 + 1024), 16, vo1, so_, 0, 0); } while (0)
#define T_DMA_R(t_, b_) do { if constexpr (MODE == 1) __builtin_amdgcn_raw_ptr_buffer_load_lds(srR, (LAS void*)(KR_lds + (b_) * SHMR + wid * 1024), 16, ro0, (t_) * rts, 0, 0); } while (0)
#define T_DMA(t_, b_) do { T_DMA_K(t_, b_); T_DMA_V(t_, b_); T_DMA_R(t_, b_); } while (0)
#define T_LANDED() do { if constexpr (MODE == 1) asm volatile("s_waitcnt vmcnt(5)" ::: "memory"); else asm volatile("s_waitcnt vmcnt(4)" ::: "memory"); } while (0)
    int vpb[8];
#pragma unroll
    for (int d = 0; d < 8; ++d) vpb[d] = (4 * fq + (fr >> 2)) * 256 + ((d ^ (4 * (fq & 1) + (fr >> 2))) * 32) + (fr & 3) * 8;
#define PK8(S0_, S1_, OUT) do { u32x4 w_ = {cvt_pk_bf16(S0_[0], S0_[1]), cvt_pk_bf16(S0_[2], S0_[3]), cvt_pk_bf16(S1_[0], S1_[1]), cvt_pk_bf16(S1_[2], S1_[3])}; OUT = __builtin_bit_cast(bf16x8, w_); } while (0)
#define VLD(L_, H_, d0) do { const unsigned a0_ = vp_ + (unsigned)vpb[2 * (d0)], a1_ = vp_ + (unsigned)vpb[2 * (d0) + 1]; \
        L_[0] = vtra<0>(a0_); H_[0] = vtra<4096>(a0_); L_[1] = vtra<8192>(a0_); H_[1] = vtra<12288>(a0_); L_[2] = vtra<0>(a1_); H_[2] = vtra<4096>(a1_); L_[3] = vtra<8192>(a1_); H_[3] = vtra<12288>(a1_); } while (0)
#define LWAIT8(L_, H_) asm volatile("s_waitcnt lgkmcnt(0)" : "+v"(L_[0]), "+v"(L_[1]), "+v"(L_[2]), "+v"(L_[3]), "+v"(H_[0]), "+v"(H_[1]), "+v"(H_[2]), "+v"(H_[3]) :: "memory")
#define VFR(L_, H_, k_) (bf16x8){L_[k_][0], L_[k_][1], L_[k_][2], L_[k_][3], H_[k_][0], H_[k_][1], H_[k_][2], H_[k_][3]}
#define VMF(L_, H_, d0) do { oacc[2 * (d0)][0] = mf16(VFR(L_, H_, 0), pb00, oacc[2 * (d0)][0]); oacc[2 * (d0)][1] = mf16(VFR(L_, H_, 0), pb01, oacc[2 * (d0)][1]); \
        oacc[2 * (d0) + 1][0] = mf16(VFR(L_, H_, 2), pb00, oacc[2 * (d0) + 1][0]); oacc[2 * (d0) + 1][1] = mf16(VFR(L_, H_, 2), pb01, oacc[2 * (d0) + 1][1]); \
        oacc[2 * (d0)][0] = mf16(VFR(L_, H_, 1), pb10, oacc[2 * (d0)][0]); oacc[2 * (d0)][1] = mf16(VFR(L_, H_, 1), pb11, oacc[2 * (d0)][1]); \
        oacc[2 * (d0) + 1][0] = mf16(VFR(L_, H_, 3), pb10, oacc[2 * (d0) + 1][0]); oacc[2 * (d0) + 1][1] = mf16(VFR(L_, H_, 3), pb11, oacc[2 * (d0) + 1][1]); } while (0)
#define PV_ALL(buf_) do { const unsigned vp_ = (unsigned)(size_t)(V_lds + (buf_) * SHMV); s16x4 la_[4], ha_[4], lb_[4], hb_[4]; \
        SBAR(); VLD(la_, ha_, 0); VLD(lb_, hb_, 1); LWAIT8(la_, ha_); LWAIT8(lb_, hb_); SBAR(); \
        VMF(la_, ha_, 0); VLD(la_, ha_, 2); SBAR(); \
        VMF(lb_, hb_, 1); VLD(lb_, hb_, 3); LWAIT8(la_, ha_); LWAIT8(lb_, hb_); SBAR(); \
        VMF(la_, ha_, 2); SBAR(); VMF(lb_, hb_, 3); SBAR(); } while (0)
#define KLD(F_, Kb_, s_) do { const LAS unsigned char* a_ = (Kb_) + kswz(fr, (32 * (s_) + 8 * fq) * 2); \
        F_[0] = *(const LAS bf16x8*)a_; F_[1] = *(const LAS bf16x8*)(a_ + 4096); F_[2] = *(const LAS bf16x8*)(a_ + 8192); F_[3] = *(const LAS bf16x8*)(a_ + 12288); } while (0)
#define KMF(F_, s_) do { sa0[0] = mf16(F_[0], qf[0][s_], sa0[0]); sa0[1] = mf16(F_[0], qf[1][s_], sa0[1]); sa1[0] = mf16(F_[1], qf[0][s_], sa1[0]); sa1[1] = mf16(F_[1], qf[1][s_], sa1[1]); \
        sa2[0] = mf16(F_[2], qf[0][s_], sa2[0]); sa2[1] = mf16(F_[2], qf[1][s_], sa2[1]); sa3[0] = mf16(F_[3], qf[0][s_], sa3[0]); sa3[1] = mf16(F_[3], qf[1][s_], sa3[1]); } while (0)
#define KRLD(F_, Kb_, s_) do { const LAS unsigned char* a_ = (Kb_) + krswz(fr, 4 * (s_) + fq); \
        F_[0] = *(const LAS bf16x8*)a_; F_[1] = *(const LAS bf16x8*)(a_ + 2048); F_[2] = *(const LAS bf16x8*)(a_ + 4096); F_[3] = *(const LAS bf16x8*)(a_ + 6144); } while (0)
#define KRMF(F_, s_) do { sa0[0] = mf16(F_[0], qrf[0][s_], sa0[0]); sa0[1] = mf16(F_[0], qrf[1][s_], sa0[1]); sa1[0] = mf16(F_[1], qrf[0][s_], sa1[0]); sa1[1] = mf16(F_[1], qrf[1][s_], sa1[1]); \
        sa2[0] = mf16(F_[2], qrf[0][s_], sa2[0]); sa2[1] = mf16(F_[2], qrf[1][s_], sa2[1]); sa3[0] = mf16(F_[3], qrf[0][s_], sa3[0]); sa3[1] = mf16(F_[3], qrf[1][s_], sa3[1]); } while (0)
    const int NT = j_hi - j_lo;
    const int qlo = P0 + wid * 32;
    bf16x8 pb00 = {}, pb01 = {}, pb10 = {}, pb11 = {};
    T_DMA(j_lo, 0);
    asm volatile("s_waitcnt vmcnt(0)" ::: "memory");
    __syncthreads();
    T_DMA((j_lo + 1 < j_hi) ? j_lo + 1 : j_hi - 1, 1);
    int cur = 0;
    for (int i = 0; i < NT; ++i) {
        const int t = j_lo + i, kb = t * 64;
        const int nxt = (cur == 2) ? 0 : cur + 1, nx2 = (cur == 0) ? 2 : cur - 1;
        const int t_ld = (t + 2 < j_hi) ? t + 2 : j_hi - 1;
        const bool need = (kb <= qlo + 31) && (kb + 63 > qlo - W);
        if (need) {
        f32x4 sa0[2], sa1[2], sa2[2], sa3[2];
#pragma unroll
        for (int c = 0; c < 2; ++c) { sa0[c] = f32x4{0.f, 0.f, 0.f, 0.f}; sa1[c] = f32x4{0.f, 0.f, 0.f, 0.f}; sa2[c] = f32x4{0.f, 0.f, 0.f, 0.f}; sa3[c] = f32x4{0.f, 0.f, 0.f, 0.f}; }
        { const LAS unsigned char* Kb = K_lds + cur * SHM; bf16x8 ka_[4], kb_[4];
          SBAR(); KLD(ka_, Kb, 0); KLD(kb_, Kb, 1); SBAR();
          KMF(ka_, 0); KLD(ka_, Kb, 2); SBAR();
          KMF(kb_, 1); KLD(kb_, Kb, 3); SBAR();
          if constexpr (MODE == 1) { const LAS unsigned char* Krb = KR_lds + cur * SHMR;
              KMF(ka_, 2); KRLD(ka_, Krb, 0); SBAR();
              KMF(kb_, 3); KRLD(kb_, Krb, 1); T_DMA_K(t_ld, nx2); SBAR();
              KRMF(ka_, 0); T_DMA_V(t_ld, nx2); SBAR(); KRMF(kb_, 1); T_DMA_R(t_ld, nx2); SBAR();
          } else { KMF(ka_, 2); T_DMA_K(t_ld, nx2); SBAR(); KMF(kb_, 3); T_DMA_V(t_ld, nx2); SBAR(); } }
        if constexpr (MODE == 0) {
            const f32x4 b0 = *(const LAS f32x4*)(biasL + kb + 4 * fq), b1 = *(const LAS f32x4*)(biasL + kb + 16 + 4 * fq), b2 = *(const LAS f32x4*)(biasL + kb + 32 + 4 * fq), b3 = *(const LAS f32x4*)(biasL + kb + 48 + 4 * fq);
#pragma unroll
            for (int c = 0; c < 2; ++c) { sa0[c] += b0; sa1[c] += b1; sa2[c] += b2; sa3[c] += b3; } }
        if (kb + 63 > qlo || kb <= qlo + 31 - W) { const int dq = qpos0 - kb - 4 * fq; const float NEG = -__builtin_inff();
#pragma unroll
          for (int c = 0; c < 2; ++c)
#pragma unroll
            for (int ii = 0; ii < 4; ++ii) { const int e = dq + 16 * c - ii;
              if ((unsigned)(e) >= (unsigned)W) sa0[c][ii] = NEG;
              if ((unsigned)(e - 16) >= (unsigned)W) sa1[c][ii] = NEG;
              if ((unsigned)(e - 32) >= (unsigned)W) sa2[c][ii] = NEG;
              if ((unsigned)(e - 48) >= (unsigned)W) sa3[c][ii] = NEG; } }
        float pm0, pm1;
        { f32x4 x0 = sa0[0], x1 = sa0[1];
#pragma unroll
          for (int ii = 0; ii < 4; ++ii) { x0[ii] = fmaxf(fmaxf(x0[ii], sa1[0][ii]), fmaxf(sa2[0][ii], sa3[0][ii])); x1[ii] = fmaxf(fmaxf(x1[ii], sa1[1][ii]), fmaxf(sa2[1][ii], sa3[1][ii])); }
          pm0 = fmaxf(fmaxf(x0[0], x0[1]), fmaxf(x0[2], x0[3])); pm1 = fmaxf(fmaxf(x1[0], x1[1]), fmaxf(x1[2], x1[3])); }
        float mn0, mn1, al0, al1;
        if (__builtin_expect(__all(fmaxf(pm0 - m0, pm1 - m1) <= THR2), 1)) { mn0 = m0; mn1 = m1; al0 = 1.f; al1 = 1.f; }
        else { pm0 = xrow16_max(pm0); pm1 = xrow16_max(pm1); mn0 = fmaxf(m0, pm0); al0 = __builtin_amdgcn_exp2f(m0 - mn0); m0 = mn0; mn1 = fmaxf(m1, pm1); al1 = __builtin_amdgcn_exp2f(m1 - mn1); m1 = mn1; }
#pragma unroll
        for (int ii = 0; ii < 4; ++ii) {
            sa0[0][ii] = __builtin_amdgcn_exp2f(sa0[0][ii] - mn0); sa1[0][ii] = __builtin_amdgcn_exp2f(sa1[0][ii] - mn0); sa2[0][ii] = __builtin_amdgcn_exp2f(sa2[0][ii] - mn0); sa3[0][ii] = __builtin_amdgcn_exp2f(sa3[0][ii] - mn0);
            sa0[1][ii] = __builtin_amdgcn_exp2f(sa0[1][ii] - mn1); sa1[1][ii] = __builtin_amdgcn_exp2f(sa1[1][ii] - mn1); sa2[1][ii] = __builtin_amdgcn_exp2f(sa2[1][ii] - mn1); sa3[1][ii] = __builtin_amdgcn_exp2f(sa3[1][ii] - mn1); }
        { f32x4 y0 = (sa0[0] + sa1[0]) + (sa2[0] + sa3[0]), y1 = (sa0[1] + sa1[1]) + (sa2[1] + sa3[1]);
          l0 = l0 * al0 + ((y0[0] + y0[1]) + (y0[2] + y0[3])); l1 = l1 * al1 + ((y1[0] + y1[1]) + (y1[2] + y1[3])); }
        PK8(sa0[0], sa1[0], pb00); PK8(sa0[1], sa1[1], pb01); PK8(sa2[0], sa3[0], pb10); PK8(sa2[1], sa3[1], pb11);
        if (__any(al0 < 1.f || al1 < 1.f)) {
#pragma unroll
            for (int d = 0; d < 8; ++d) { oacc[d][0] *= al0; oacc[d][1] *= al1; } }
        PV_ALL(cur);
        } else T_DMA(t_ld, nx2);
        T_LANDED();
        __syncthreads();
        cur = nxt;
    }
    asm volatile("s_waitcnt vmcnt(0)" ::: "memory");
#undef PV_ALL
#undef VMF
#undef VFR
#undef VLD
#undef LWAIT8
#undef KLD
#undef KMF
#undef KRLD
#undef KRMF
#undef PK8
#undef T_DMA
#undef T_DMA_K
#undef T_DMA_V
#undef T_DMA_R
#undef T_LANDED
    l0 = pg8::xrow16_sum(l0); l1 = pg8::xrow16_sum(l1);
    float lsum[2] = {l0, l1}, mrow[2] = {m0, m1};
#pragma unroll
    for (int c = 0; c < 2; ++c) {
        const long qi = wid * 32 + 16 * c + fr;
        const float lse2 = mrow[c] + __builtin_amdgcn_logf(lsum[c]);
        float wgt = __builtin_amdgcn_rcpf(lsum[c]); float w2 = 0.f, w3 = 0.f;
        if constexpr (MODE == 2) { if (fq == 0) B.Lo[qi * B.ls] = lse2; }
        if constexpr (MODE == 3) { const float a2 = B.L2[qi * B.l23s], a3 = B.L3[qi * B.l23s];
            const float mx = fmaxf(lse2, fmaxf(a2, a3)); const float e1 = __builtin_amdgcn_exp2f(lse2 - mx), e2 = __builtin_amdgcn_exp2f(a2 - mx), e3 = __builtin_amdgcn_exp2f(a3 - mx);
            const float inv = __builtin_amdgcn_rcpf(e1 + e2 + e3); wgt = e1 * inv * wgt; w2 = e2 * inv; w3 = e3 * inv; }
        bf16_t* Ow = B.O + qi * B.os + 4 * fq;
#pragma unroll
        for (int d = 0; d < 8; ++d) { f32x4 v = oacc[d][c] * wgt;
            if constexpr (MODE == 3) { const long po = qi * B.o23s + 16 * d + 4 * fq; const u32x2 u2 = *(const u32x2*)(B.O2 + po), u3 = *(const u32x2*)(B.O3 + po);
                v[0] += w2 * __uint_as_float(u2.x << 16) + w3 * __uint_as_float(u3.x << 16); v[1] += w2 * __uint_as_float(u2.x & 0xffff0000u) + w3 * __uint_as_float(u3.x & 0xffff0000u);
                v[2] += w2 * __uint_as_float(u2.y << 16) + w3 * __uint_as_float(u3.y << 16); v[3] += w2 * __uint_as_float(u2.y & 0xffff0000u) + w3 * __uint_as_float(u3.y & 0xffff0000u); }
            u32x2 w; w.x = cvt_pk_bf16(v[0], v[1]); w.y = cvt_pk_bf16(v[2], v[3]); *(u32x2*)(Ow + 16 * d) = w; } }
    __syncthreads();
}
__device__ __forceinline__ void fox_bias_table(const float* logf, int b, int h, LAS unsigned char* lds) {
    int tid_o = threadIdx.x; asm volatile("" : "+v"(tid_o));
    const int tid = tid_o, wid = tid >> 6, lane = tid & 63;
    LAS float* biasL = (LAS float*)(lds + OFF_CUM); LAS float* wsum = (LAS float*)(lds + OFF_WS);
    float v[8]; float run = 0.f;
#pragma unroll
    for (int i = 0; i < 8; ++i) { run += logf[((size_t)b * SEQ + 8 * tid + i) * 4 + h]; v[i] = run; }
    float sc = run;
#pragma unroll
    for (int o = 1; o < 64; o <<= 1) { const float n = __shfl_up(sc, o); if (lane >= o) sc += n; }
    const float excl = sc - run;
    __syncthreads();
    if (lane == 63) wsum[wid] = sc;
    __syncthreads();
    float wpre = 0.f;
    for (int w = 0; w < wid; ++w) wpre += wsum[w];
#pragma unroll
    for (int i = 0; i < 8; ++i) biasL[8 * tid + i] = -(v[i] + excl + wpre) * LOG2E;
    __syncthreads();
}
#undef SBAR
}

#define XB_TMO      128
#define XB_XCNT(j)  (256  + 64 * (j))
#define XB_XSUB(j)  (1280 + 64 * (j))
#define XB_XGEN(j)  (2304 + 64 * (j))
#define XB_TOP      3328
#define XB_TOPGEN   3392
#define XCD_BAR_WORDS 3456
#define XB_SPIN_CAP (1u << 18)
__device__ __forceinline__ unsigned xb_ld(unsigned* p)              { return __hip_atomic_load(p, __ATOMIC_RELAXED, __HIP_MEMORY_SCOPE_AGENT); }
__device__ __forceinline__ unsigned xb_add(unsigned* p, unsigned v) { return __hip_atomic_fetch_add(p, v, __ATOMIC_RELAXED, __HIP_MEMORY_SCOPE_AGENT); }
__device__ __forceinline__ unsigned xb_xcc_id() { return (unsigned)__builtin_amdgcn_s_getreg((3 << 11) | 20) & 0xFu; }
#define XB_SPIN(cond, bar) do { unsigned _sp = 0; while (cond) { __builtin_amdgcn_s_sleep(1); \
    if ((++_sp & 255u) == 0u) { if (xb_ld(&(bar)[XB_TMO])) break; if (_sp > XB_SPIN_CAP) { atomicAdd(&(bar)[XB_TMO], 1u); break; } } } } while (0)
struct XcdBarrier { unsigned* bar; unsigned x; volatile LAS unsigned* st; };
__device__ __forceinline__ XcdBarrier xcd_barrier_post(unsigned* bar, volatile LAS unsigned* st) {
    XcdBarrier b; b.bar = bar; b.x = xb_xcc_id(); b.st = st;
    if (threadIdx.x == 0) (void)xb_add(&bar[XB_XCNT(b.x)], 1u);
    return b;
}
__device__ __forceinline__ void xcd_barrier_complete(unsigned* bar, unsigned x, unsigned& nloc, unsigned& nx) {
    const unsigned G = gridDim.x * gridDim.y * gridDim.z;
    unsigned sum, cnt, mine, sp = 0u;
    for (;;) {
        sum = 0u; cnt = 0u; mine = 0u;
#pragma unroll
        for (unsigned j = 0; j < 16; ++j) { const unsigned c = xb_ld(&bar[XB_XCNT(j)]); sum += c; cnt += (c > 0u) ? 1u : 0u; mine = (j == x) ? c : mine; }
        if (sum == G) break;
        __builtin_amdgcn_s_sleep(1);
        if ((++sp & 255u) == 0u) { if (xb_ld(&bar[XB_TMO])) break; if (sp > XB_SPIN_CAP) { atomicAdd(&bar[XB_TMO], 1u); break; } }
    }
    nloc = mine > 0u ? mine : 1u; nx = cnt > 0u ? cnt : 1u;
}
__device__ __forceinline__ void xcd_barrier(const XcdBarrier& b) {
    asm volatile("s_waitcnt vmcnt(0)" ::: "memory");
    __syncthreads();
    if (threadIdx.x == 0) {
        unsigned* bar = b.bar;
        __builtin_amdgcn_s_waitcnt(0);
        unsigned nloc = b.st[0], nx = b.st[1];
        if (nloc == 0u) { xcd_barrier_complete(bar, b.x, nloc, nx); b.st[0] = nloc; b.st[1] = nx; }
        const unsigned old = xb_add(&bar[XB_XSUB(b.x)], 1u);
        const unsigned gen = old / nloc;
        if (old + 1u == (gen + 1u) * nloc) {
            __builtin_amdgcn_fence(__ATOMIC_RELEASE, "agent");
            asm volatile("s_waitcnt vmcnt(0)" ::: "memory");
            const unsigned og = xb_add(&bar[XB_TOP], 1u);
            const unsigned tg = og / nx;
            if (og + 1u == (tg + 1u) * nx) xb_add(&bar[XB_TOPGEN], 1u);
            else XB_SPIN(xb_ld(&bar[XB_TOPGEN]) == tg, bar);
            __builtin_amdgcn_fence(__ATOMIC_ACQUIRE, "agent");
            xb_add(&bar[XB_XGEN(b.x)], 1u);
            asm volatile("s_waitcnt vmcnt(0)" ::: "memory");
        } else {
            XB_SPIN(xb_ld(&bar[XB_XGEN(b.x)]) == gen, bar);
            __builtin_amdgcn_fence(__ATOMIC_ACQUIRE, "agent");
            asm volatile("s_waitcnt vmcnt(0)" ::: "memory");
        }
    }
    __syncthreads();
}

__device__ __forceinline__ unsigned f2bf(float f) { unsigned u = __builtin_bit_cast(unsigned, f); return (u + 0x7fffu + ((u >> 16) & 1u)) >> 16; }
__device__ __forceinline__ unsigned pk2(float lo, float hi) { return f2bf(lo) | (f2bf(hi) << 16); }
__device__ __forceinline__ void cvt_item(const float* W, int ldw, const float* gain, bf16_t* WT, int K, int n0, int k0, int src4, LAS float* scr, int lane) {
    const int kq = lane >> 3, c4 = lane & 7;
    f32x4 v[8]; float g[8];
#pragma unroll
    for (int i = 0; i < 8; ++i) { v[i] = (src4 >= 0) ? *(const f32x4*)(W + (size_t)(k0 + 8 * i + kq) * ldw + src4) : (f32x4){0.f, 0.f, 0.f, 0.f}; g[i] = gain ? gain[k0 + 8 * i + kq] : 1.0f; }
#pragma unroll
    for (int i = 0; i < 8; ++i) { LAS float* d = scr + (8 * i + kq) * 33 + 4 * c4; const f32x4 w = v[i] * g[i]; d[0] = w[0]; d[1] = w[1]; d[2] = w[2]; d[3] = w[3]; }
    LDS_WAIT(); asm volatile("" ::: "memory");
    const int c = lane & 7;
#pragma unroll
    for (int j = 0; j < 4; ++j) { const int n = (lane >> 3) + 8 * j; const LAS float* s = scr + (8 * c) * 33 + n;
        u32x4 o; o.x = pk2(s[0 * 33], s[1 * 33]); o.y = pk2(s[2 * 33], s[3 * 33]); o.z = pk2(s[4 * 33], s[5 * 33]); o.w = pk2(s[6 * 33], s[7 * 33]);
        *(u32x4*)(WT + (size_t)(n0 + n) * K + k0 + 8 * c) = o; }
    LDS_WAIT(); asm volatile("" ::: "memory");
}
__device__ __forceinline__ int map_win(int n) {
    if (n < 1536) return n;
    if (n < 2560) return 1540 + (n - 1536);
    if (n < 4096) return 2628 + (n - 2560);
    if (n < 4160) { const int p = n - 4096, wc = p >> 5, nn = (p >> 4) & 1, r = p & 15; return 2564 + 16 * wc + r + 32 * nn; }
    if (n < 4164) return 1536 + (n - 4160);
    return -1;
}
__device__ __forceinline__ int map_uq(int n) {
    if (n < 1024) return (n >> 7) * 192 + (n & 127);
    const int p = n - 1024, head = p >> 6, pp = p & 63, w1 = pp >> 5, nn = (pp >> 4) & 1, r = pp & 15;
    return head * 192 + 128 + 16 * w1 + r + 32 * nn;
}
__device__ __forceinline__ void sincos_acc(float ang, float& s, float& c) {
    const double a = (double)ang; const double k = rint(a * 0.63661977236758134308);
    double r = fma(-k, 1.57079632679489655800e+00, a); r = fma(-k, 6.12323399573676603587e-17, r);
    const double r2 = r * r;
    double sp = -2.50521083854417187751e-08; sp = fma(sp, r2, 2.75573192239858906526e-06); sp = fma(sp, r2, -1.98412698412698412698e-04); sp = fma(sp, r2, 8.33333333333333333333e-03); sp = fma(sp, r2, -1.66666666666666666667e-01);
    const double sn = fma(r * r2, sp, r);
    double cp = 2.08767569878680989792e-09; cp = fma(cp, r2, -2.75573192239858906526e-07); cp = fma(cp, r2, 2.48015873015873015873e-05); cp = fma(cp, r2, -1.38888888888888888889e-03); cp = fma(cp, r2, 4.16666666666666666667e-02); cp = fma(cp, r2, -0.5);
    const double cs = fma(r2, cp, 1.0);
    const int q = ((int)k) & 3;
    const double ss = (q == 0) ? sn : (q == 1) ? cs : (q == 2) ? -sn : -cs;
    const double cc = (q == 0) ? cs : (q == 1) ? -sn : (q == 2) ? -cs : sn;
    s = (float)ss; c = (float)cc;
}

constexpr int NWAVES = 8;
#ifndef MK_SITE_MASK
#define MK_SITE_MASK 0xFFF
#endif
#ifndef MK_REP_MASK
#define MK_REP_MASK 0x0
#define MK_REP_N 1
#endif
#ifndef MK_EPI_REP
#define MK_EPI_REP 1
#endif
#define NREP(i) ((((MK_REP_MASK) >> (i)) & 1) ? MK_REP_N : 1)
#define REP(i) for (int rep = 0; rep < NREP(i); ++rep)
constexpr int RING_BYTES = 131072, MISC_OFF = RING_BYTES + 320, LDS_BYTES = 147456;
constexpr int NPHASE = 2 + 8 * DEPTH;

struct Args { const float* in[18]; float* out; unsigned char* ws; int ph_lo, ph_hi, use_bar, pad; };

__global__ void __launch_bounds__(NWAVES * 64, 2) mk_fwd(Args args) {
    extern __shared__ __attribute__((aligned(16))) unsigned char lds_raw[];
    LAS unsigned char* lds = (LAS unsigned char*)lds_raw;
    volatile LAS unsigned* MISC = (volatile LAS unsigned*)(lds + MISC_OFF);
    const int G = gridDim.x; const int bx = blockIdx.x; const int vcu = (G % 8 == 0) ? (bx % 8) * (G / 8) + bx / 8 : bx;
    unsigned char* ws = args.ws;
    unsigned* ctl = (unsigned*)(ws + WS_CTL);
    for (int u = threadIdx.x; u < (LDS_BYTES - RING_BYTES) / 4; u += NWAVES * 64) ((LAS unsigned*)(lds + RING_BYTES))[u] = 0u;
    __syncthreads();
    XcdBarrier bar; bar.bar = ctl + CW_BAR; bar.x = 0; bar.st = nullptr;
    if (args.use_bar) bar = xcd_barrier_post(ctl + CW_BAR, MISC + 8);
    const int lo = args.ph_lo, hi = args.ph_hi;
#define IN(k) (lo <= (k) && (k) < hi)
#define EN(i) (((MK_SITE_MASK) >> (i)) & 1)
#define SEAM(k) do { if (args.use_bar && IN((k) + 1)) xcd_barrier(bar); } while (0)

    const float* x_in = args.in[0];
    float* xres = args.out;
#define WSL GAS unsigned char* wsl = (GAS unsigned char*)ws; asm volatile("" : "+s"(wsl))
#define XB ((bf16_t*)(GAS bf16_t*)(wsl + WS_XB))
#define ACT ((bf16_t*)(GAS bf16_t*)(wsl + WS_BIG))
#define P ((bf16_t*)(GAS bf16_t*)(wsl + WS_P))
#define KR ((bf16_t*)(GAS bf16_t*)(wsl + WS_KR))
#define QBN ((bf16_t*)(GAS bf16_t*)(wsl + WS_QBN))
#define QBR ((bf16_t*)(GAS bf16_t*)(wsl + WS_QBR))
#define KVB ((bf16_t*)(GAS bf16_t*)(wsl + WS_KVB))
#define MIX ((bf16_t*)(GAS bf16_t*)(wsl + WS_MIX))
#define DILO ((bf16_t*)(GAS bf16_t*)(wsl + WS_DILO))
#define SSQ ((float*)(GAS float*)(wsl + WS_SSQ))
#define SSQQ ((float*)(GAS float*)(wsl + WS_SSQQ))
#define SSQKV ((float*)(GAS float*)(wsl + WS_SSQKV))
#define LOGF ((float*)(GAS float*)(wsl + WS_LOGF))
#define LSE ((float*)(GAS float*)(wsl + WS_LSE))
#define COSM ((float*)(GAS float*)(wsl + WS_COSM))
#define SINM ((float*)(GAS float*)(wsl + WS_SINM))
#define COSP ((float*)(GAS float*)(wsl + WS_COSP))
#define SINP ((float*)(GAS float*)(wsl + WS_SINP))
    const int NGW = G * NWAVES;
#define SITE_LANE int tid_o = threadIdx.x; asm volatile("" : "+v"(tid_o)); const int tid = tid_o, lane = tid & 63, wave = __builtin_amdgcn_readfirstlane(tid >> 6), gw = vcu * NWAVES + wave; (void)tid; (void)lane; (void)gw

    if (EN(0) && IN(0)) { WSL; SITE_LANE;
        REP(0) {
        LAS float* scr = (LAS float*)(lds + wave * 16384);
        constexpr int I_GU = (DM / 64) * (NGU / 32), I_DN = (FF / 64) * (DM / 32), I_IN = (DM / 64) * (INP / 32), I_UQ = (512 / 64) * (1536 / 32), I_UKV = (512 / 64) * (2048 / 32), I_OUT = (DM / 64) * (DM / 32);
        constexpr int I_LAYER = 2 * I_GU + 2 * I_DN + I_IN + I_UQ + I_UKV + I_OUT;
        for (int it = gw; it < DEPTH * I_LAYER; it += NGW) {
            const int l = it / I_LAYER; int r = it - l * I_LAYER;
            unsigned char* wl = ws + WS_W + (size_t)l * W_LAYER;
            const int nl = 4 * (lane & 7);
            if (r < 2 * I_GU) { const int f2 = r >= I_GU; if (f2) r -= I_GU; const int nblk = NGU / 32, kb = r / nblk, nb = r % nblk, n0 = 32 * nb;
                const int tile = n0 >> 8, within = n0 & 255; const bool up = within >= 128; const int col = tile * 128 + (within & 127) + nl;
                const float* W = args.in[(f2 ? 14 : 2) + (up ? 1 : 0)] + (size_t)l * DM * FF; const float* gain = args.in[f2 ? 13 : 1] + (size_t)l * DM;
                cvt_item(W, FF, gain, (bf16_t*)(wl + (f2 ? WO_GU2 : WO_GU1)), DM, n0, 64 * kb, col, scr, lane); continue; }
            r -= 2 * I_GU;
            if (r < 2 * I_DN) { const int f2 = r >= I_DN; if (f2) r -= I_DN; const int nblk = DM / 32, kb = r / nblk, nb = r % nblk, n0 = 32 * nb;
                const float* W = args.in[f2 ? 16 : 4] + (size_t)l * FF * DM;
                cvt_item(W, DM, nullptr, (bf16_t*)(wl + (f2 ? WO_DN2 : WO_DN1)), FF, n0, 64 * kb, n0 + nl, scr, lane); continue; }
            r -= 2 * I_DN;
            if (r < I_IN) { const int nblk = INP / 32, kb = r / nblk, nb = r % nblk, n0 = 32 * nb;
                cvt_item(args.in[6] + (size_t)l * DM * IN_W, IN_W, args.in[5] + (size_t)l * DM, (bf16_t*)(wl + WO_IN), DM, n0, 64 * kb, map_win(n0 + nl), scr, lane); continue; }
            r -= I_IN;
            if (r < I_UQ) { const int nblk = 1536 / 32, kb = r / nblk, nb = r % nblk, n0 = 32 * nb;
                cvt_item(args.in[10] + (size_t)l * 512 * 1536, 1536, args.in[8] + (size_t)l * 512, (bf16_t*)(wl + WO_UQ), 512, n0, 64 * kb, map_uq(n0 + nl), scr, lane); continue; }
            r -= I_UQ;
            if (r < I_UKV) { const int nblk = 2048 / 32, kb = r / nblk, nb = r % nblk, n0 = 32 * nb;
                cvt_item(args.in[11] + (size_t)l * 512 * 2048, 2048, args.in[9] + (size_t)l * 512, (bf16_t*)(wl + WO_UKV), 512, n0, 64 * kb, n0 + nl, scr, lane); continue; }
            r -= I_UKV;
            { const int nblk = DM / 32, kb = r / nblk, nb = r % nblk, n0 = 32 * nb;
              cvt_item(args.in[12] + (size_t)l * DM * DM, DM, nullptr, (bf16_t*)(wl + WO_OUT), DM, n0, 64 * kb, n0 + nl, scr, lane); }
        }
        for (int i = bx * (NWAVES * 64) + tid; i < SEQ * 48; i += G * NWAVES * 64) {
            const int s = i / 48, j = i % 48; float sn, cs;
            if (j < 32) { const float inv = 1.0f / powf(500000.0f, (float)(2 * j) / 64.0f); sincos_acc((float)s * inv, sn, cs); COSM[s * 32 + j] = cs; SINM[s * 32 + j] = sn; }
            else { const int jj = j - 32; const float inv = 1.0f / powf(500000.0f, (float)(2 * jj) / 32.0f); sincos_acc((float)s * inv, sn, cs); COSP[s * 16 + jj] = cs; SINP[s * 16 + jj] = sn; }
        }
        for (int m = gw; m < M; m += NGW) { const f32x4* xr = (const f32x4*)(x_in + (size_t)m * DM) + lane; float s = 0.f;
            u32x2* o8 = (u32x2*)(XB + (size_t)m * DM) + lane;
#pragma unroll
            for (int j = 0; j < 8; ++j) { const f32x4 v = xr[64 * j]; s += (v[0] * v[0] + v[1] * v[1]) + (v[2] * v[2] + v[3] * v[3]); u32x2 w; w.x = cvt_pk_bf16(v[0], v[1]); w.y = cvt_pk_bf16(v[2], v[3]); o8[64 * j] = w; }
#pragma unroll
            for (int o = 1; o < 64; o <<= 1) s += __shfl_xor(s, o);
            if (lane < 32) SSQ[(size_t)m * 32 + lane] = (lane == 0) ? s : 0.f; }
        }
        VM_WAIT(); __syncthreads();
        SEAM(0);
    }

    for (int l = 0; l < DEPTH; ++l) {
        const int pb = 1 + 8 * l;
        unsigned char* wl = ws + WS_W + (size_t)l * W_LAYER;
        for (int half = 0; half < 2; ++half) {
        if (EN(1) && IN(pb + 6 * half)) { WSL; pg8::Gemm g{XB, (const bf16_t*)(wl + (half ? WO_GU2 : WO_GU1)), DM, DM, M, NGU, DM}; pg8::EpiGateUp E{wsl}; REP(1) { pg8::StaticOrder S; S.init(M, NGU, G, bx); pg8::gemm_phase<pg8::EpiGateUp, true>(lds, g, S, E); } SEAM(pb + 6 * half); }
        if (EN(2) && IN(pb + 6 * half + 1)) { WSL; pg8::Gemm g{ACT, (const bf16_t*)(wl + (half ? WO_DN2 : WO_DN1)), 64, FF, M, DM, FF, 256 * 64 * 2, (FF / 64) * 256 * 64 * 2}; REP(2) { pg8::StaticOrder S; S.init(M, DM, G, bx, 4); pg8::EpiResid E{XB, (rep + 1 < NREP(2)) ? (bf16_t*)(GAS bf16_t*)(wsl + WS_KVB) : XB, wsl, 0.5f}; pg8::gemm_phase<pg8::EpiResid, true>(lds, g, S, E); } SEAM(pb + 6 * half + 1); }
        if (half) break;
        if (EN(3) && IN(pb + 2)) { WSL; pg8::Gemm g{XB, (const bf16_t*)(wl + WO_IN), DM, DM, M, INP, DM}; pg8::EpiWin E{wsl, args.in[7] + l * 4};
            REP(3) { pg8::StaticOrder S; S.init(M, INP, G, bx); pg8::gemm_phase<pg8::EpiWin, true>(lds, g, S, E); } SEAM(pb + 2); }
        if (IN(pb + 3)) {
            if (EN(4)) { WSL; pg8::Gemm g{P + PC_CQ, (const bf16_t*)(wl + WO_UQ), PP, 512, M, 1536, 512}; pg8::EpiUq E{wsl}; REP(4) { pg8::StaticOrder S; S.init(M, 1536, G, bx); pg8::gemm_phase<pg8::EpiUq, true>(lds, g, S, E); } }
            if (EN(5)) { WSL; pg8::Gemm g{P + PC_CKV, (const bf16_t*)(wl + WO_UKV), PP, 512, M, 2048, 512}; pg8::EpiUkv E{wsl}; REP(5) { pg8::StaticOrder S; S.init(M, 2048, G, bx); pg8::gemm_phase<pg8::EpiUkv, true>(lds, g, S, E); } }
            if (EN(6)) REP(6) for (int it = vcu; it < 1024; it += G) { WSL;
                const int br = it >> 9, i2 = it & 511, bh = i2 >> 4, sub = i2 & 15; const int b = bh >> 2, h = bh & 3;
                const int d = br ? 16 : 4; const int res = br ? sub : (sub >> 2), qb = br ? 0 : (sub & 3);
                const size_t row0 = (size_t)b * SEQ + res;
                att::Blk B{}; B.qs = (long)PP * d; B.ks = B.qs; B.vs = B.qs; B.os = 512L * d; B.ls = 4L * d; B.P0 = qb * 256; B.W = 129;
                B.Q = P + (row0 + (size_t)qb * 256 * d) * PP + PC_DQ + h * HD; B.K = P + row0 * PP + PC_DK + h * HD; B.V = P + row0 * PP + PC_DV + h * HD;
                B.O = DILO + (size_t)br * M * 512 + (row0 + (size_t)qb * 256 * d) * 512 + h * HD; B.Lo = LSE + (size_t)br * M * 4 + (row0 + (size_t)qb * 256 * d) * 4 + h;
                att::attn_block<2>(B, lds);
            }
            SEAM(pb + 3);
        }
        if (IN(pb + 4)) {
            if (EN(7)) REP(7) for (int it = vcu; it < 256; it += G) { WSL; const int bh = it >> 3, x = it & 7, b = bh >> 2, h = bh & 3;
                att::fox_bias_table(LOGF, b, h, lds);
                for (int pass = 0; pass < 2; ++pass) { const int qb = pass ? 15 - x : x; const size_t row0 = (size_t)b * SEQ;
                    att::Blk B{}; B.qs = PP; B.ks = PP; B.vs = PP; B.os = 2048; B.P0 = qb * 256; B.W = 1 << 20;
                    B.Q = P + (row0 + (size_t)qb * 256) * PP + PC_FQ + h * HD; B.K = P + row0 * PP + PC_FK + h * HD; B.V = P + row0 * PP + PC_FV + h * HD;
                    B.O = MIX + (row0 + (size_t)qb * 256) * 2048 + h * HD;
                    att::attn_block<0>(B, lds); } }
            if (EN(8)) REP(8) for (int it = vcu; it < 512; it += G) { WSL; const int bh = it >> 3, x = it & 7, b = bh >> 3, h = bh & 7;
                for (int pass = 0; pass < 2; ++pass) { const int qb = pass ? 15 - x : x; const size_t row0 = (size_t)b * SEQ;
                    att::Blk B{}; B.qs = 1024; B.qrs = 512; B.ks = 2048; B.krs = 64; B.vs = 2048; B.os = 2048; B.P0 = qb * 256; B.W = 1 << 20;
                    B.Q = QBN + (row0 + (size_t)qb * 256) * 1024 + h * HD; B.Qr = QBR + (row0 + (size_t)qb * 256) * 512 + h * 64;
                    B.K = KVB + row0 * 2048 + h * 256; B.Kr = KR + row0 * 64; B.V = KVB + row0 * 2048 + h * 256 + HD;
                    B.O = MIX + (row0 + (size_t)qb * 256) * 2048 + 512 + h * HD;
                    att::attn_block<1>(B, lds); } }
            if (EN(9)) REP(9) for (int it = vcu; it < 512; it += G) { WSL; const int bh = it >> 4, qb = it & 15, b = bh >> 2, h = bh & 3; const size_t row0 = (size_t)b * SEQ, rq = row0 + (size_t)qb * 256;
                att::Blk B{}; B.qs = PP; B.ks = PP; B.vs = PP; B.os = 2048; B.P0 = qb * 256; B.W = 129;
                B.Q = P + rq * PP + PC_DQ + h * HD; B.K = P + row0 * PP + PC_DK + h * HD; B.V = P + row0 * PP + PC_DV + h * HD;
                B.O = MIX + rq * 2048 + 1536 + h * HD;
                B.O2 = DILO + rq * 512 + h * HD; B.O3 = DILO + (size_t)M * 512 + rq * 512 + h * HD; B.L2 = LSE + rq * 4 + h; B.L3 = LSE + (size_t)M * 4 + rq * 4 + h; B.o23s = 512; B.l23s = 4;
                att::attn_block<3>(B, lds); }
            SEAM(pb + 4);
        }
        if (EN(10) && IN(pb + 5)) { WSL; pg8::Gemm g{MIX, (const bf16_t*)(wl + WO_OUT), DM, DM, M, DM, DM}; REP(10) { pg8::StaticOrder S; S.init(M, DM, G, bx, 4); pg8::EpiResid E{XB, (rep + 1 < NREP(10)) ? (bf16_t*)(GAS bf16_t*)(wsl + WS_P) : XB, wsl, 1.0f}; pg8::gemm_phase<pg8::EpiResid, true>(lds, g, S, E); } SEAM(pb + 5); }
        }
    }
    if (EN(11) && IN(NPHASE - 1)) { WSL; SITE_LANE;
        const float* gf = args.in[17];
        for (int m = gw; m < M; m += NGW) { float s = (lane < 32) ? SSQ[(size_t)m * 32 + lane] : 0.f;
#pragma unroll
            for (int o = 1; o < 64; o <<= 1) s += __shfl_xor(s, o);
            const float r = __builtin_amdgcn_rsqf(s * (1.0f / DM) + EPS);
            const u32x4* xr = (const u32x4*)(XB + (size_t)m * DM) + lane; f32x4* orow = (f32x4*)(xres + (size_t)m * DM); const f32x4* gr = (const f32x4*)gf;
#pragma unroll
            for (int j = 0; j < 4; ++j) { const u32x4 b = xr[64 * j]; const int c = (64 * j + lane) * 2;
                f32x4 v0, v1; v0[0] = __uint_as_float(b.x << 16); v0[1] = __uint_as_float(b.x & 0xffff0000u); v0[2] = __uint_as_float(b.y << 16); v0[3] = __uint_as_float(b.y & 0xffff0000u);
                v1[0] = __uint_as_float(b.z << 16); v1[1] = __uint_as_float(b.z & 0xffff0000u); v1[2] = __uint_as_float(b.w << 16); v1[3] = __uint_as_float(b.w & 0xffff0000u);
                orow[c] = v0 * r * gr[c]; orow[c + 1] = v1 * r * gr[c + 1]; } }
    }
#undef IN
#undef SEAM
#undef EN
}

#ifndef MK_ONE_LAUNCH
#define MK_ONE_LAUNCH 1
#endif
extern "C" void kernel_launch(void* const* d_in, const int* in_sizes, int n_in, void* d_out, int out_size, void* d_ws, size_t ws_size, hipStream_t stream) {
    static int grid = 0;
    if (grid == 0) {
        if (n_in != 18 || in_sizes[0] != M * DM || out_size != M * DM || ws_size < WS_END) {
            fprintf(stderr, "kernel_launch: shape/workspace mismatch (n_in %d, in0 %d, out %d, ws %zu, need %zu)\n", n_in, n_in > 0 ? in_sizes[0] : -1, out_size, ws_size, (size_t)WS_END); grid = -1; return; }
        int dev = 0, cus = 0;
        if (hipGetDevice(&dev) != hipSuccess || hipDeviceGetAttribute(&cus, hipDeviceAttributeMultiprocessorCount, dev) != hipSuccess) { grid = -1; return; }
        if (hipFuncSetAttribute((const void*)mk_fwd, hipFuncAttributeMaxDynamicSharedMemorySize, LDS_BYTES) != hipSuccess) { fprintf(stderr, "kernel_launch: hipFuncSetAttribute failed\n"); grid = -1; return; }
        int per_cu = 0;
        if (hipOccupancyMaxActiveBlocksPerMultiprocessor(&per_cu, (const void*)mk_fwd, NWAVES * 64, LDS_BYTES) != hipSuccess || per_cu < 1) fprintf(stderr, "kernel_launch: occupancy query says %d\n", per_cu);
        (void)hipGetLastError();
        grid = cus;
    }
    if (grid < 0) return;
    if (hipMemsetAsync((char*)d_ws + WS_CTL, 0, CTL_ZERO_BYTES, stream) != hipSuccess) return;
    Args a{};
    for (int i = 0; i < 18; ++i) a.in[i] = (const float*)d_in[i];
    a.out = (float*)d_out; a.ws = (unsigned char*)d_ws;
#if MK_ONE_LAUNCH
    a.ph_lo = 0; a.ph_hi = NPHASE; a.use_bar = 1;
    hipLaunchKernelGGL(mk_fwd, dim3(grid), dim3(NWAVES * 64), LDS_BYTES, stream, a);
#else
    for (int p = 0; p < NPHASE; ++p) { a.ph_lo = p; a.ph_hi = p + 1; a.use_bar = 0;
        hipLaunchKernelGGL(mk_fwd, dim3(grid), dim3(NWAVES * 64), LDS_BYTES, stream, a); }
#endif
}
```

```cpp
#include <hip/hip_runtime.h>
#include <cstdio>
#include <cstdint>

#ifndef MK_EPI_REP
#define MK_EPI_REP 1
#endif
#define LAS __attribute__((address_space(3)))
#define GAS __attribute__((address_space(1)))
typedef unsigned short bf16_t;
typedef short bf16x8 __attribute__((ext_vector_type(8)));
typedef short s16x4 __attribute__((ext_vector_type(4)));
typedef float f32x4 __attribute__((ext_vector_type(4)));
typedef float f32x2 __attribute__((ext_vector_type(2)));
typedef float f32x16 __attribute__((ext_vector_type(16)));
typedef unsigned u32x4 __attribute__((ext_vector_type(4)));
typedef unsigned u32x2 __attribute__((ext_vector_type(2)));

constexpr int BATCH = 8, SEQ = 4096, DM = 2048, DEPTH = 4, FF = 5632, HD = 128;
constexpr int M = BATCH * SEQ;
constexpr int IN_W = 4164, INP = 4352;
constexpr int NGU = 2 * FF;
constexpr float EPS = 1e-6f;
constexpr float LOG2E = 1.4426950408889634f;
constexpr float C2_FOX = 0.08838834764831845f * LOG2E;
constexpr float C2_DIL = C2_FOX;
constexpr float C2_MLA = 0.07216878364870322f * LOG2E;
constexpr int PP = 4096;
constexpr int PC_FQ = 0, PC_FK = 512, PC_FV = 1024, PC_CQ = 1536, PC_CKV = 2048, PC_DQ = 2560, PC_DK = 3072, PC_DV = 3584;

constexpr size_t MiB = 1u << 20;
constexpr size_t WS_CTL = 0, CTL_ZERO_BYTES = 1 * MiB;
constexpr size_t WS_COSM = 1 * MiB;
constexpr size_t WS_SINM = WS_COSM + 512 * 1024;
constexpr size_t WS_COSP = 2 * MiB;
constexpr size_t WS_SINP = WS_COSP + 256 * 1024;
constexpr size_t WS_SSQ = 4 * MiB;
constexpr size_t WS_SSQQ = 8 * MiB;
constexpr size_t WS_SSQKV = 9 * MiB;
constexpr size_t WS_LOGF = 10 * MiB;
constexpr size_t WS_LSE = 11 * MiB;
constexpr size_t WS_W = 16 * MiB;
constexpr size_t W_GU = (size_t)NGU * DM * 2, W_DN = (size_t)DM * FF * 2, W_IN = (size_t)INP * DM * 2, W_UQ = (size_t)1536 * 512 * 2, W_UKV = (size_t)2048 * 512 * 2, W_OUT = (size_t)DM * DM * 2;
constexpr size_t WO_GU1 = 0, WO_DN1 = WO_GU1 + W_GU, WO_IN = WO_DN1 + W_DN, WO_UQ = WO_IN + W_IN, WO_UKV = WO_UQ + W_UQ, WO_OUT = WO_UKV + W_UKV, WO_GU2 = WO_OUT + W_OUT, WO_DN2 = WO_GU2 + W_GU, W_LAYER = WO_DN2 + W_DN;
constexpr size_t WS_XB = WS_W + DEPTH * W_LAYER;
constexpr size_t WS_BIG = WS_XB + (size_t)M * DM * 2;
constexpr size_t WS_P = WS_BIG;
constexpr size_t WS_KR = WS_P + (size_t)M * PP * 2;
constexpr size_t WS_QBN = WS_KR + (size_t)M * 64 * 2;
constexpr size_t WS_QBR = WS_QBN + (size_t)M * 1024 * 2;
constexpr size_t WS_KVB = WS_QBR + (size_t)M * 512 * 2;
constexpr size_t WS_MIX = WS_KVB + (size_t)M * 2048 * 2;
constexpr size_t WS_DILO = WS_MIX + (size_t)M * 2048 * 2;
constexpr size_t WS_END = WS_DILO + (size_t)2 * M * 512 * 2;
static_assert(W_LAYER % 256 == 0 && WS_BIG + (size_t)M * FF * 2 <= WS_END, "ws map");

constexpr int CW_BAR = 4096;

__device__ __forceinline__ unsigned cvt_pk_bf16(float lo, float hi) { unsigned r; asm volatile("v_cvt_pk_bf16_f32 %0, %1, %2" : "=v"(r) : "v"(lo), "v"(hi)); return r; }
__device__ __forceinline__ float bf2f(unsigned short h) { return __uint_as_float((unsigned)h << 16); }
#define LDS_WAIT() asm volatile("s_waitcnt lgkmcnt(0)" ::: "memory")
#define VM_WAIT() asm volatile("s_waitcnt vmcnt(0)" ::: "memory")

namespace pg8 {
constexpr int BM = 256, BK = 64, HALF = 128, HTB = HALF * BK * 2, STAGE_BYTES = 8 * HTB, NXCD = 8, WGM = 8;
__host__ __device__ __forceinline__ int lds_byte(int r, int c) { const int st = (r >> 4) * 2 + (c >> 5), rr = r & 15, cc = c & 31, ob = rr * 64 + cc * 2; return st * 1024 + (ob ^ (((ob >> 9) & 1) << 5)); }
__host__ __device__ __forceinline__ void stage_rc(int b, int& R, int& C) { const int st = b / 1024, sb = b % 1024, swz = sb ^ (((sb >> 9) & 1) << 5); R = (st >> 1) * 16 + swz / 64; C = (st & 1) * 32 + (swz % 64) / 2; }
__host__ __device__ __forceinline__ int perm32(int rho) { const int n = rho >> 4, i = rho & 15; return 8 * (i >> 2) + 4 * n + (i & 3); }
struct Unit { int pm, pn; };
struct Gemm { const bf16_t* A; const bf16_t* Bt; int lda, ldb, M, N, K; int kstepA = BK * 2, tstepA = 0; };
struct StaticOrder {
    int nM, nN, nwg, G, c, wgm;
    __host__ __device__ void init(int M_, int N_, int G_, int c_, int wgm_ = WGM) { nM = M_ / BM; nN = N_ / BM; nwg = nM * nN; G = G_; c = c_; wgm = wgm_; }
    __host__ __device__ bool next(int i, Unit& u) const {
        const long L = (long)i * G + c; if (L >= nwg) return false;
        int wgid = (int)L; { const int q = nwg / NXCD, r = nwg % NXCD, xcd = wgid % NXCD, off = wgid / NXCD; wgid = (xcd < r ? xcd * (q + 1) : r * (q + 1) + (xcd - r) * q) + off; }
        const int nig = wgm * nN, gid = wgid / nig, fm = gid * wgm, gsz = (nM - fm) < wgm ? (nM - fm) : wgm;
        u.pm = fm + ((wgid % nig) % gsz); u.pn = (wgid % nig) / gsz; return true;
    }
};
template <class Epi, bool ALIGN_EPI>
__device__ __forceinline__ void gemm_phase(LAS unsigned char* lds, const Gemm g, const StaticOrder& S, const Epi& E) {
    int tid_o = threadIdx.x; asm volatile("" : "+v"(tid_o));
    const int tid = tid_o, wid = __builtin_amdgcn_readfirstlane(tid >> 6), lane = tid & 63, wr = wid >> 2, wc = wid & 3, fr = lane & 15, fq = lane >> 4;
    const int K = g.K, nt = K / BK;
    unsigned voffA[2], voffB[2];
#pragma unroll
    for (int i = 0; i < 2; ++i) { int R, C; stage_rc(tid * 16 + i * 8192, R, C); const int Rb = Epi::PERM ? ((R & ~31) + perm32(R & 31)) : R;
        voffA[i] = (unsigned)(R * g.lda + C) * 2u; voffB[i] = (unsigned)(Rb * g.ldb + C) * 2u; }
    const size_t kstep = (size_t)(BK * 2), kstepA = (size_t)g.kstepA;
    const size_t hstepA = (size_t)HALF * g.lda * 2, hstepB = (size_t)HALF * g.ldb * 2;
    const size_t tstepA = g.tstepA ? (size_t)g.tstepA : 2 * hstepA, tstepB = 2 * hstepB;
    const unsigned ldsw = (unsigned)wid * 1024u;
    const __amdgpu_buffer_rsrc_t srdA = __builtin_amdgcn_make_buffer_rsrc((void*)g.A, (short)0, 0x7fffffff, 0x00020000), srdB = __builtin_amdgcn_make_buffer_rsrc((void*)g.Bt, (short)0, 0x7fffffff, 0x00020000);
    const int aoff = lds_byte(wr * 64 + fr, fq * 8), boff = lds_byte(wc * 32 + fr, fq * 8);
#define PG8_SA(b, h) (((b) * 2 + (h)) * HTB)
#define PG8_SB(b, h) ((4 + (b) * 2 + (h)) * HTB)
#define PG8_STAGE(srd, base0, bufoff, gbase, voff) do { const unsigned so_ = (unsigned)((const char*)(gbase) - (const char*)(base0)); _Pragma("unroll") for (int _i = 0; _i < 2; ++_i) \
        __builtin_amdgcn_raw_ptr_buffer_load_lds(srd, (LAS void*)(lds + (bufoff) + ldsw + _i * 8192), 16, (int)(voff)[_i], (int)so_, 0, 0); } while (0)
#define PG8_LDA(dst, b, h) do { _Pragma("unroll") for (int m = 0; m < 4; ++m) _Pragma("unroll") for (int k = 0; k < 2; ++k) dst[m][k] = *(const LAS bf16x8*)(lds + PG8_SA(b, h) + aoff + m * 2048 + k * 1024); } while (0)
#define PG8_LDB(dst, b, h) do { _Pragma("unroll") for (int n = 0; n < 2; ++n) _Pragma("unroll") for (int k = 0; k < 2; ++k) dst[n][k] = *(const LAS bf16x8*)(lds + PG8_SB(b, h) + boff + n * 2048 + k * 1024); } while (0)
#define PG8_MMA(ai, bj, At, Bt) do { __builtin_amdgcn_s_setprio(1); _Pragma("unroll") for (int m = 0; m < 4; ++m) _Pragma("unroll") for (int n = 0; n < 2; ++n) _Pragma("unroll") for (int k = 0; k < 2; ++k) \
        acc[ai][bj][m][n] = __builtin_amdgcn_mfma_f32_16x16x32_bf16(Bt[n][k], At[m][k], acc[ai][bj][m][n], 0, 0, 0); __builtin_amdgcn_s_setprio(0); } while (0)
#define PG8_WAIT_V(n) asm volatile("s_waitcnt vmcnt(" #n ")" ::: "memory")
#define PG8_WAIT_L(n) asm volatile("s_waitcnt lgkmcnt(" #n ")" ::: "memory")
#define PG8_BAR __builtin_amdgcn_s_barrier()
#define PG8_SCHED __builtin_amdgcn_sched_barrier(0)
    Unit cur, nxt; int ui = 0;
    if (!S.next(0, cur)) return;
    __builtin_amdgcn_s_waitcnt(0x0F70);
    LAS float* rc = (LAS float*)(lds + STAGE_BYTES + 1024) + wid * 144;
    *(volatile LAS int*)(rc + 128) = -1;
    f32x4 acc[2][2][4][2];
#pragma unroll
    for (int a = 0; a < 2; ++a)
#pragma unroll
        for (int b = 0; b < 2; ++b)
#pragma unroll
            for (int m = 0; m < 4; ++m)
#pragma unroll
                for (int n = 0; n < 2; ++n) acc[a][b][m][n] = (f32x4){0.f, 0.f, 0.f, 0.f};
    bf16x8 At[4][2], B0[2][2], B1[2][2];
    const char* cA = (const char*)g.A + (size_t)cur.pm * tstepA; const char* cB = (const char*)g.Bt + (size_t)cur.pn * tstepB;
    PG8_STAGE(srdB, g.Bt, PG8_SB(0, 0), cB, voffB); PG8_STAGE(srdB, g.Bt, PG8_SB(0, 1), cB + hstepB, voffB); PG8_STAGE(srdA, g.A, PG8_SA(0, 0), cA, voffA); PG8_STAGE(srdA, g.A, PG8_SA(0, 1), cA + hstepA, voffA);
    if (wr == 1) PG8_BAR;
    PG8_WAIT_V(2); PG8_BAR;
    PG8_STAGE(srdB, g.Bt, PG8_SB(1, 0), cB + kstep, voffB); PG8_STAGE(srdA, g.A, PG8_SA(1, 0), cA + kstepA, voffA); PG8_STAGE(srdB, g.Bt, PG8_SB(1, 1), cB + hstepB + kstep, voffB);
    PG8_WAIT_V(6); PG8_BAR;
    for (;;) {
        const bool has_next = S.next(ui + 1, nxt);
        const char* nA = has_next ? (const char*)g.A + (size_t)nxt.pm * tstepA : cA; const char* nB = has_next ? (const char*)g.Bt + (size_t)nxt.pn * tstepB : cB;
        for (int t = 0; t < nt; t += 2) {
            const bool last = (t == nt - 2);
            const char* a1 = cA + (size_t)(t + 1) * kstepA;
            const char* a2 = last ? nA : cA + (size_t)(t + 2) * kstepA; const char* b2 = last ? nB : cB + (size_t)(t + 2) * kstep;
            const char* a3 = a2 + kstepA; const char* b3 = b2 + kstep;
            PG8_LDB(B0, 0, 0); PG8_LDB(B1, 0, 1); PG8_SCHED; PG8_LDA(At, 0, 0); PG8_STAGE(srdA, g.A, PG8_SA(1, 1), a1 + hstepA, voffA);
            PG8_WAIT_V(8); PG8_WAIT_L(0); PG8_BAR; PG8_MMA(0, 0, At, B0); PG8_MMA(0, 1, At, B1); PG8_BAR; PG8_SCHED;
            PG8_LDA(At, 0, 1); PG8_STAGE(srdB, g.Bt, PG8_SB(0, 0), b2, voffB); PG8_STAGE(srdB, g.Bt, PG8_SB(0, 1), b2 + hstepB, voffB); PG8_STAGE(srdA, g.A, PG8_SA(0, 0), a2, voffA);
            PG8_WAIT_V(8); PG8_WAIT_L(0); PG8_BAR; PG8_MMA(1, 0, At, B0); PG8_MMA(1, 1, At, B1); PG8_BAR; PG8_SCHED;
            PG8_LDB(B0, 1, 0); PG8_LDB(B1, 1, 1); PG8_SCHED; PG8_LDA(At, 1, 0); PG8_STAGE(srdA, g.A, PG8_SA(0, 1), a2 + hstepA, voffA);
            PG8_WAIT_V(8); PG8_WAIT_L(0); PG8_BAR; PG8_MMA(0, 0, At, B0); PG8_MMA(0, 1, At, B1); PG8_BAR; PG8_SCHED;
            PG8_LDA(At, 1, 1); PG8_STAGE(srdB, g.Bt, PG8_SB(1, 0), b3, voffB); PG8_STAGE(srdB, g.Bt, PG8_SB(1, 1), b3 + hstepB, voffB); PG8_STAGE(srdA, g.A, PG8_SA(1, 0), a3, voffA);
            PG8_WAIT_V(8); PG8_WAIT_L(0); PG8_BAR; PG8_MMA(1, 0, At, B0); PG8_MMA(1, 1, At, B1); PG8_BAR; PG8_SCHED;
        }
        if constexpr (ALIGN_EPI) { if (wr == 0) PG8_BAR; }
        E(acc, cur, wr, wc, fr, fq, rc);
        if constexpr (Epi::EREP > 1) { for (int er_ = 1; er_ < Epi::EREP; ++er_) { asm volatile("" ::: "memory"); E(acc, cur, wr, wc, fr, fq, rc); } }
        if (!has_next) break;
#pragma unroll
        for (int a = 0; a < 2; ++a)
#pragma unroll
            for (int b = 0; b < 2; ++b)
#pragma unroll
                for (int m = 0; m < 4; ++m)
#pragma unroll
                    for (int n = 0; n < 2; ++n) acc[a][b][m][n] = (f32x4){0.f, 0.f, 0.f, 0.f};
        cur = nxt; cA = nA; cB = nB; ++ui;
        if constexpr (ALIGN_EPI) { if (wr == 1) PG8_BAR; }
    }
    PG8_WAIT_V(0);
    if constexpr (!ALIGN_EPI) { if (wr == 0) PG8_BAR; }
    PG8_BAR;
#undef PG8_SA
#undef PG8_SB
#undef PG8_STAGE
#undef PG8_LDA
#undef PG8_LDB
#undef PG8_MMA
#undef PG8_WAIT_V
#undef PG8_WAIT_L
#undef PG8_BAR
#undef PG8_SCHED
}

__device__ __forceinline__ float xrow16_sum(float x) {
    auto s = __builtin_amdgcn_permlane16_swap(__float_as_uint(x), __float_as_uint(x), false, false);
    x = __uint_as_float(s[0]) + __uint_as_float(s[1]);
    auto t = __builtin_amdgcn_permlane32_swap(__float_as_uint(x), __float_as_uint(x), false, false);
    return __uint_as_float(t[0]) + __uint_as_float(t[1]);
}
template <int NP> __device__ __forceinline__ void load_rstd(const float* ssq, int row0, int fq, float inv_n, float (&rs)[2][4]) {
    float sv[8];
    if constexpr (NP == 32) {
#pragma unroll
        for (int h = 0; h < 2; ++h) { f32x4 a[4], b[4];
#pragma unroll
            for (int i = 0; i < 4; ++i) { const float* p = ssq + (size_t)(row0 + h * HALF + i * 16) * 32 + 8 * fq; a[i] = *(const f32x4*)p; b[i] = *(const f32x4*)(p + 4); }
#pragma unroll
            for (int i = 0; i < 4; ++i) sv[4 * h + i] = ((a[i][0] + a[i][1]) + (a[i][2] + a[i][3])) + ((b[i][0] + b[i][1]) + (b[i][2] + b[i][3]));
            asm volatile("" ::: "memory"); }
    } else { f32x2 a[8];
#pragma unroll
        for (int i = 0; i < 8; ++i) a[i] = *(const f32x2*)(ssq + (size_t)(row0 + (i >> 2) * HALF + (i & 3) * 16) * 8 + 2 * fq);
#pragma unroll
        for (int i = 0; i < 8; ++i) sv[i] = a[i][0] + a[i][1];
    }
#pragma unroll
    for (int i = 0; i < 8; ++i) sv[i] = xrow16_sum(sv[i]);
#pragma unroll
    for (int i = 0; i < 8; ++i) rs[i >> 2][i & 3] = __builtin_amdgcn_rsqf(sv[i] * inv_n + EPS);
}
template <int NP> __device__ __forceinline__ void load_rstd_cached(const float* ssq, int row0, int fq, int fr, float inv_n, float (&rs)[2][4], LAS float* rc, int pm) {
    const int tag = __builtin_amdgcn_readfirstlane(*(volatile LAS int*)(rc + 128));
    if (tag == pm) {
#pragma unroll
        for (int i = 0; i < 8; ++i) rs[i >> 2][i & 3] = rc[i * 16 + fr];
    } else {
        load_rstd<NP>(ssq, row0, fq, inv_n, rs);
        if (fq == 0) {
#pragma unroll
            for (int i = 0; i < 8; ++i) rc[i * 16 + fr] = rs[i >> 2][i & 3]; }
        *(volatile LAS int*)(rc + 128) = pm;
    }
}
struct EpiGateUp {
    static constexpr bool PERM = true; static constexpr int EREP = MK_EPI_REP;
    GAS unsigned char* ws;
    __device__ __forceinline__ void operator()(const f32x4 (&acc)[2][2][4][2], const Unit& u, int wr, int wc, int fr, int fq, LAS float* rc) const {
        bf16_t* O = (bf16_t*)(GAS bf16_t*)(ws + WS_BIG); const float* ssq = (const float*)(GAS float*)(ws + WS_SSQ);
        const int row0 = u.pm * BM + wr * 64 + fr, col0 = u.pn * HALF + wc * 32 + 8 * fq;
        float rs[2][4]; load_rstd_cached<32>(ssq, row0, fq, fr, 1.0f / DM, rs, rc, u.pm);
#pragma unroll
        for (int ai = 0; ai < 2; ++ai)
#pragma unroll
            for (int m = 0; m < 4; ++m) { const float r = rs[ai][m], c1 = -r * LOG2E, R = __builtin_amdgcn_rcpf(r * r); f32x2 t[4], gu[4];
#pragma unroll
                for (int i = 0; i < 4; ++i) { const f32x2 g = {acc[ai][0][m][i >> 1][2 * (i & 1)], acc[ai][0][m][i >> 1][2 * (i & 1) + 1]}, uu = {acc[ai][1][m][i >> 1][2 * (i & 1)], acc[ai][1][m][i >> 1][2 * (i & 1) + 1]};
                    t[i] = g * c1; gu[i] = g * uu; }
#pragma unroll
                for (int i = 0; i < 4; ++i) { t[i].x = __builtin_amdgcn_exp2f(t[i].x); t[i].y = __builtin_amdgcn_exp2f(t[i].y); }
#pragma unroll
                for (int i = 0; i < 4; ++i) { t[i].x = __builtin_fmaf(t[i].x, R, R); t[i].y = __builtin_fmaf(t[i].y, R, R); }
#pragma unroll
                for (int i = 0; i < 4; ++i) { t[i].x = __builtin_amdgcn_rcpf(t[i].x); t[i].y = __builtin_amdgcn_rcpf(t[i].y); }
#pragma unroll
                for (int i = 0; i < 4; ++i) gu[i] = gu[i] * t[i];
                u32x4 w; w.x = cvt_pk_bf16(gu[0].x, gu[0].y); w.y = cvt_pk_bf16(gu[1].x, gu[1].y); w.z = cvt_pk_bf16(gu[2].x, gu[2].y); w.w = cvt_pk_bf16(gu[3].x, gu[3].y);
                { const int row = row0 + ai * HALF + m * 16;
                  *(u32x4*)(O + ((size_t)((row >> 8) * (FF / 64) + (col0 >> 6)) * 256 + (row & 255)) * 64 + (col0 & 63)) = w; } }
    }
};
struct EpiResid {
    static constexpr bool PERM = true; static constexpr int EREP = 1;
    const bf16_t* base; bf16_t* outb; GAS unsigned char* ws; float scale;
    __device__ __forceinline__ void operator()(const f32x4 (&acc)[2][2][4][2], const Unit& u, int wr, int wc, int fr, int fq, LAS float* rc) const {
        float* ssq = (float*)(GAS float*)(ws + WS_SSQ);
        const int row0 = u.pm * BM + wr * 64 + fr, col0 = u.pn * BM + wc * 32 + 8 * fq;
#pragma unroll
        for (int hb = 0; hb < 2; ++hb) {
        u32x4 pre[4][2];
#pragma unroll
        for (int g4 = 0; g4 < 4; ++g4) { const size_t off = (size_t)(row0 + hb * HALF + g4 * 16) * DM + col0;
            pre[g4][0] = *(const u32x4*)(base + off); pre[g4][1] = *(const u32x4*)(base + off + HALF); }
#pragma unroll
        for (int g4 = 0; g4 < 4; ++g4) { const int ai = hb, m = g4, row = row0 + ai * HALF + m * 16; const size_t off = (size_t)row * DM + col0; float sq = 0.f;
            f32x2 sq2 = {0.f, 0.f};
#pragma unroll
            for (int bj = 0; bj < 2; ++bj) { const u32x4 b = pre[g4][bj];
                f32x2 x0 = {__uint_as_float(b.x << 16), __uint_as_float(b.x & 0xffff0000u)}, x1 = {__uint_as_float(b.y << 16), __uint_as_float(b.y & 0xffff0000u)};
                f32x2 x2 = {__uint_as_float(b.z << 16), __uint_as_float(b.z & 0xffff0000u)}, x3 = {__uint_as_float(b.w << 16), __uint_as_float(b.w & 0xffff0000u)};
                const f32x4 a0 = acc[ai][bj][m][0], a1 = acc[ai][bj][m][1];
                x0 = x0 + (f32x2){a0[0], a0[1]} * scale; x1 = x1 + (f32x2){a0[2], a0[3]} * scale; x2 = x2 + (f32x2){a1[0], a1[1]} * scale; x3 = x3 + (f32x2){a1[2], a1[3]} * scale;
                u32x4 w; w.x = cvt_pk_bf16(x0.x, x0.y); w.y = cvt_pk_bf16(x1.x, x1.y); w.z = cvt_pk_bf16(x2.x, x2.y); w.w = cvt_pk_bf16(x3.x, x3.y);
                *(u32x4*)(outb + off + bj * HALF) = w;
                sq2 = sq2 + x0 * x0; sq2 = sq2 + x1 * x1; sq2 = sq2 + x2 * x2; sq2 = sq2 + x3 * x3; }
            sq = sq2.x + sq2.y;
            sq = xrow16_sum(sq); if (fq == 0) ssq[(size_t)row * 32 + u.pn * 4 + wc] = sq; }
        asm volatile("" ::: "memory"); }
    }
};
struct EpiWin {
    static constexpr bool PERM = false; static constexpr int EREP = 1;
    GAS unsigned char* ws; const float* fbias;
    __device__ __forceinline__ void operator()(const f32x4 (&acc)[2][2][4][2], const Unit& u, int wr, int wc, int fr, int fq, LAS float* rc) const {
        bf16_t* P = (bf16_t*)(GAS bf16_t*)(ws + WS_P); bf16_t* KR = (bf16_t*)(GAS bf16_t*)(ws + WS_KR); float* logf = (float*)(GAS float*)(ws + WS_LOGF); const float* ssq = (const float*)(GAS float*)(ws + WS_SSQ);
        float* ssqq = (float*)(GAS float*)(ws + WS_SSQQ); float* ssqkv = (float*)(GAS float*)(ws + WS_SSQKV);
        const float* cosp = (const float*)(GAS float*)(ws + WS_COSP); const float* sinp = (const float*)(GAS float*)(ws + WS_SINP); const float* cosm = (const float*)(GAS float*)(ws + WS_COSM); const float* sinm = (const float*)(GAS float*)(ws + WS_SINM);
        const int row0 = u.pm * BM + wr * 64 + fr;
        float rs[2][4]; load_rstd_cached<32>(ssq, row0, fq, fr, 1.0f / DM, rs, rc, u.pm);
        const int pn = u.pn, grp = pn >> 1;
        if (pn < 16) {
            const float sc = (grp == 0) ? C2_FOX : (grp == 5) ? C2_DIL : 1.0f;
            const bool rope = (grp == 5 || grp == 6) && wc == 0;
            float* sq_dst = (grp == 3) ? ssqq : (grp == 4) ? ssqkv : nullptr;
#pragma unroll
            for (int ai = 0; ai < 2; ++ai)
#pragma unroll
                for (int m = 0; m < 4; ++m) { const int row = row0 + ai * HALF + m * 16; const float r = rs[ai][m]; const int s = row & (SEQ - 1); float sq = 0.f;
#pragma unroll
                    for (int bj = 0; bj < 2; ++bj) { f32x4 v0 = acc[ai][bj][m][0] * r, v1 = acc[ai][bj][m][1] * r;
                        sq += (v0[0] * v0[0] + v0[1] * v0[1]) + (v0[2] * v0[2] + v0[3] * v0[3]) + (v1[0] * v1[0] + v1[1] * v1[1]) + (v1[2] * v1[2] + v1[3] * v1[3]);
                        if (rope) { const f32x4 c = *(const f32x4*)(cosp + s * 16 + 4 * fq), sn = *(const f32x4*)(sinp + s * 16 + 4 * fq);
                            const f32x4 a = v0 * c - v1 * sn, b = v0 * sn + v1 * c; v0 = a; v1 = b; }
                        v0 = v0 * sc; v1 = v1 * sc;
                        bf16_t* p = P + (size_t)row * PP + pn * BM + bj * HALF + wc * 32 + 4 * fq;
                        u32x2 w0, w1; w0.x = cvt_pk_bf16(v0[0], v0[1]); w0.y = cvt_pk_bf16(v0[2], v0[3]); w1.x = cvt_pk_bf16(v1[0], v1[1]); w1.y = cvt_pk_bf16(v1[2], v1[3]);
                        *(u32x2*)p = w0; *(u32x2*)(p + 16) = w1; }
                    if (sq_dst) { sq = xrow16_sum(sq); if (fq == 0) sq_dst[(size_t)row * 8 + (pn & 1) * 4 + wc] = sq; } }
        } else {
            if (wc < 2) {
#pragma unroll
                for (int ai = 0; ai < 2; ++ai)
#pragma unroll
                    for (int m = 0; m < 4; ++m) { const int row = row0 + ai * HALF + m * 16; const float r = rs[ai][m]; const int s = row & (SEQ - 1); const int d = 16 * wc + 4 * fq;
                        const f32x4 x1 = acc[ai][0][m][0] * r, x2 = acc[ai][0][m][1] * r;
                        const f32x4 c = *(const f32x4*)(cosm + s * 32 + d), sn = *(const f32x4*)(sinm + s * 32 + d);
                        const f32x4 a = x1 * c - x2 * sn, b = x1 * sn + x2 * c;
                        u32x2 w0, w1; w0.x = cvt_pk_bf16(a[0], a[1]); w0.y = cvt_pk_bf16(a[2], a[3]); w1.x = cvt_pk_bf16(b[0], b[1]); w1.y = cvt_pk_bf16(b[2], b[3]);
                        *(u32x2*)(KR + (size_t)row * 64 + d) = w0; *(u32x2*)(KR + (size_t)row * 64 + d + 32) = w1; }
            } else if (wc == 2 && fq == 0) {
                const f32x4 fb = *(const f32x4*)fbias;
#pragma unroll
                for (int ai = 0; ai < 2; ++ai)
#pragma unroll
                    for (int m = 0; m < 4; ++m) { const int row = row0 + ai * HALF + m * 16; const f32x4 z = acc[ai][0][m][0] * rs[ai][m] + fb; f32x4 o;
#pragma unroll
                        for (int j = 0; j < 4; ++j) { const float az = fabsf(z[j]); o[j] = fminf(z[j], 0.f) - log1pf(__expf(-az)); }
                        *(f32x4*)(logf + (size_t)row * 4) = o; }
            }
        }
    }
};
struct EpiUq {
    static constexpr bool PERM = false; static constexpr int EREP = 1;
    GAS unsigned char* ws;
    __device__ __forceinline__ void operator()(const f32x4 (&acc)[2][2][4][2], const Unit& u, int wr, int wc, int fr, int fq, LAS float* rc) const {
        bf16_t* QBn = (bf16_t*)(GAS bf16_t*)(ws + WS_QBN); bf16_t* QBr = (bf16_t*)(GAS bf16_t*)(ws + WS_QBR); const float* ssqq = (const float*)(GAS float*)(ws + WS_SSQQ);
        const float* cosm = (const float*)(GAS float*)(ws + WS_COSM); const float* sinm = (const float*)(GAS float*)(ws + WS_SINM);
        const int row0 = u.pm * BM + wr * 64 + fr;
        float rs[2][4]; load_rstd<8>(ssqq, row0, fq, 1.0f / 512, rs);
        const int pn = u.pn;
#pragma unroll
        for (int ai = 0; ai < 2; ++ai)
#pragma unroll
            for (int m = 0; m < 4; ++m) { const int row = row0 + ai * HALF + m * 16; const float r = rs[ai][m] * C2_MLA; const int s = row & (SEQ - 1);
#pragma unroll
                for (int bj = 0; bj < 2; ++bj) { const f32x4 v0 = acc[ai][bj][m][0] * r, v1 = acc[ai][bj][m][1] * r;
                    if (pn < 4) { bf16_t* p = QBn + (size_t)row * 1024 + pn * BM + bj * HALF + wc * 32 + 4 * fq;
                        u32x2 w0, w1; w0.x = cvt_pk_bf16(v0[0], v0[1]); w0.y = cvt_pk_bf16(v0[2], v0[3]); w1.x = cvt_pk_bf16(v1[0], v1[1]); w1.y = cvt_pk_bf16(v1[2], v1[3]);
                        *(u32x2*)p = w0; *(u32x2*)(p + 16) = w1; }
                    else { const int head = (pn - 4) * 4 + 2 * bj + (wc >> 1), d = 16 * (wc & 1) + 4 * fq;
                        const f32x4 c = *(const f32x4*)(cosm + s * 32 + d), sn = *(const f32x4*)(sinm + s * 32 + d);
                        const f32x4 a = v0 * c - v1 * sn, b = v0 * sn + v1 * c;
                        u32x2 w0, w1; w0.x = cvt_pk_bf16(a[0], a[1]); w0.y = cvt_pk_bf16(a[2], a[3]); w1.x = cvt_pk_bf16(b[0], b[1]); w1.y = cvt_pk_bf16(b[2], b[3]);
                        bf16_t* p = QBr + (size_t)row * 512 + head * 64 + d; *(u32x2*)p = w0; *(u32x2*)(p + 32) = w1; } } }
    }
};
struct EpiUkv {
    static constexpr bool PERM = true; static constexpr int EREP = 1;
    GAS unsigned char* ws;
    __device__ __forceinline__ void operator()(const f32x4 (&acc)[2][2][4][2], const Unit& u, int wr, int wc, int fr, int fq, LAS float* rc) const {
        bf16_t* KVB = (bf16_t*)(GAS bf16_t*)(ws + WS_KVB); const float* ssqkv = (const float*)(GAS float*)(ws + WS_SSQKV);
        const int row0 = u.pm * BM + wr * 64 + fr, col0 = u.pn * BM + wc * 32 + 8 * fq;
        float rs[2][4]; load_rstd<8>(ssqkv, row0, fq, 1.0f / 512, rs);
#pragma unroll
        for (int ai = 0; ai < 2; ++ai)
#pragma unroll
            for (int m = 0; m < 4; ++m) { const float r = rs[ai][m]; bf16_t* rowp = KVB + (size_t)(row0 + ai * HALF + m * 16) * 2048 + col0;
#pragma unroll
                for (int bj = 0; bj < 2; ++bj) { const f32x4 v0 = acc[ai][bj][m][0] * r, v1 = acc[ai][bj][m][1] * r;
                    u32x4 w; w.x = cvt_pk_bf16(v0[0], v0[1]); w.y = cvt_pk_bf16(v0[2], v0[3]); w.z = cvt_pk_bf16(v1[0], v1[1]); w.w = cvt_pk_bf16(v1[2], v1[3]);
                    *(u32x4*)(rowp + bj * HALF) = w; } }
    }
};
}

namespace att {
#define SBAR() __builtin_amdgcn_sched_barrier(0)
constexpr int SHM = 16384, SHMR = 8192;
constexpr int SHMV = SHM;
constexpr int OFF_V = 0, OFF_K = 3 * SHMV, OFF_KR = OFF_K + 3 * SHM, OFF_CUM = OFF_KR, ATT_LDS = OFF_KR + 3 * SHMR, OFF_WS = 131072 + 8192;
constexpr float THR2 = 24.0f;
static_assert(ATT_LDS <= 131072, "attention LDS");
__device__ __forceinline__ int kswz(int row, int colB) { return row * 256 + (colB ^ ((row & 15) << 4)); }
__device__ __forceinline__ int krswz(int row, int chunk) { return row * 128 + ((chunk ^ ((row >> 1) & 7)) << 4); }
typedef short v4i16_t __attribute__((ext_vector_type(4)));
__device__ __forceinline__ s16x4 vtr(const LAS unsigned char* p) { return __builtin_bit_cast(s16x4, __builtin_amdgcn_ds_read_tr16_b64_v4i16((LAS v4i16_t*)p)); }
__device__ __forceinline__ float xrow16_max(float x) {
    auto s = __builtin_amdgcn_permlane16_swap(__float_as_uint(x), __float_as_uint(x), false, false);
    x = fmaxf(__uint_as_float(s[0]), __uint_as_float(s[1]));
    auto t = __builtin_amdgcn_permlane32_swap(__float_as_uint(x), __float_as_uint(x), false, false);
    return fmaxf(__uint_as_float(t[0]), __uint_as_float(t[1]));
}
template <int OFF> __device__ __forceinline__ s16x4 vtra(unsigned a) { s16x4 r; asm volatile("ds_read_b64_tr_b16 %0, %1 offset:%2" : "=v"(r) : "v"(a), "n"(OFF) : "memory"); return r; }
__device__ __forceinline__ f32x4 mf16(bf16x8 a, bf16x8 b, f32x4 c) { return __builtin_amdgcn_mfma_f32_16x16x32_bf16(a, b, c, 0, 0, 0); }

struct Blk {
    const bf16_t* Q; long qs;
    const bf16_t* Qr; long qrs;
    const bf16_t* K; long ks;
    const bf16_t* Kr; long krs;
    const bf16_t* V; long vs;
    bf16_t* O; long os;
    float* Lo; long ls;
    const bf16_t* O2; const bf16_t* O3; const float* L2; const float* L3; long o23s; long l23s;
    int P0; int W;
};
template <int MODE>
__device__ __forceinline__ void attn_block(const Blk& B, LAS unsigned char* lds) {
    int tid_o = threadIdx.x; asm volatile("" : "+v"(tid_o));
    const int tid = tid_o, wid = __builtin_amdgcn_readfirstlane(tid >> 6), lane = tid & 63, fr = lane & 15, fq = lane >> 4;
    LAS unsigned char* V_lds = lds + OFF_V; LAS unsigned char* K_lds = lds + OFF_K; LAS unsigned char* KR_lds = lds + OFF_KR;
    const LAS float* biasL = (const LAS float*)(lds + OFF_CUM);
    bf16x8 qf[2][4]; bf16x8 qrf[2][2];
#pragma unroll
    for (int c = 0; c < 2; ++c) { const bf16_t* qp = B.Q + (long)(wid * 32 + 16 * c + fr) * B.qs + fq * 8;
#pragma unroll
        for (int s_ = 0; s_ < 4; ++s_) qf[c][s_] = *(const bf16x8*)(qp + 32 * s_);
        if constexpr (MODE == 1) { const bf16_t* qp2 = B.Qr + (long)(wid * 32 + 16 * c + fr) * B.qrs + fq * 8;
#pragma unroll
            for (int s_ = 0; s_ < 2; ++s_) qrf[c][s_] = *(const bf16x8*)(qp2 + 32 * s_); } }
    const int W = B.W, P0 = B.P0;
    const int lowk = P0 - W + 1; const int j_lo = lowk > 0 ? lowk / 64 : 0; const int j_hi = (P0 + 255) / 64 + 1;
    const int qpos0 = P0 + wid * 32 + fr;
    float m0 = -1e30f, m1 = -1e30f, l0 = 0.f, l1 = 0.f;
    f32x4 oacc[8][2];
#pragma unroll
    for (int d = 0; d < 8; ++d) { oacc[d][0] = f32x4{0.f, 0.f, 0.f, 0.f}; oacc[d][1] = f32x4{0.f, 0.f, 0.f, 0.f}; }
    const int dr = 8 * wid + (lane >> 4);
    const int kof0 = ((lane & 15) ^ (dr & 15)) * 8, kof1 = ((lane & 15) ^ ((dr + 4) & 15)) * 8;
    const int vof0 = ((((lane & 15) >> 1) ^ (dr & 7)) * 16) + (lane & 1) * 8, vof1 = ((((lane & 15) >> 1) ^ ((dr + 4) & 7)) * 16) + (lane & 1) * 8;
    const int rr = 8 * wid + (lane >> 3); const int rof = ((lane & 7) ^ ((rr >> 1) & 7)) * 8;
    constexpr int NDMA = (MODE == 1) ? 5 : 4;
    const __amdgpu_buffer_rsrc_t srK = __builtin_amdgcn_make_buffer_rsrc((void*)B.K, (short)0, 0x7fffffff, 0x00020000), srV = __builtin_amdgcn_make_buffer_rsrc((void*)B.V, (short)0, 0x7fffffff, 0x00020000);
    const __amdgpu_buffer_rsrc_t srR = __builtin_amdgcn_make_buffer_rsrc((void*)(MODE == 1 ? B.Kr : B.K), (short)0, 0x7fffffff, 0x00020000);
    const int ko0 = (int)((dr * B.ks + kof0) * 2), ko1 = (int)(((dr + 4) * B.ks + kof1) * 2), vo0 = (int)((dr * B.vs + vof0) * 2), vo1 = (int)(((dr + 4) * B.vs + vof1) * 2), ro0 = (int)((rr * B.krs + rof) * 2);
    const int kts = (int)(B.ks * 128), vts = (int)(B.vs * 128), rts = (int)(B.krs * 128);
#define T_DMA_K(t_, b_) do { const int so_ = (t_) * kts; \
        __builtin_amdgcn_raw_ptr_buffer_load_lds(srK, (LAS void*)(K_lds + (b_) * SHM + wid * 2048), 16, ko0, so_, 0, 0); \
        __builtin_amdgcn_raw_ptr_buffer_load_lds(srK, (LAS void*)(K_lds + (b_) * SHM + wid * 2048 + 1024), 16, ko1, so_, 0, 0); } while (0)
#define T_DMA_V(t_, b_) do { const int so_ = (t_) * vts; \
        __builtin_amdgcn_raw_ptr_buffer_load_lds(srV, (LAS void*)(V_lds + (b_) * SHMV + wid * 2048), 16, vo0, so_, 0, 0); \
        __builtin_amdgcn_raw_ptr_buffer_load_lds(srV, (LAS void*)(V_lds + (b_) * SHMV + wid * 2048 + 1024), 16, vo1, so_, 0, 0); } while (0)
#define T_DMA_R(t_, b_) do { if constexpr (MODE == 1) __builtin_amdgcn_raw_ptr_buffer_load_lds(srR, (LAS void*)(KR_lds + (b_) * SHMR + wid * 1024), 16, ro0, (t_) * rts, 0, 0); } while (0)
#define T_DMA(t_, b_) do { T_DMA_K(t_, b_); T_DMA_V(t_, b_); T_DMA_R(t_, b_); } while (0)
#define T_LANDED() do { if constexpr (MODE == 1) asm volatile("s_waitcnt vmcnt(5)" ::: "memory"); else asm volatile("s_waitcnt vmcnt(4)" ::: "memory"); } while (0)
    int vpb[8];
#pragma unroll
    for (int d = 0; d < 8; ++d) vpb[d] = (4 * fq + (fr >> 2)) * 256 + ((d ^ (4 * (fq & 1) + (fr >> 2))) * 32) + (fr & 3) * 8;
#define PK8(S0_, S1_, OUT) do { u32x4 w_ = {cvt_pk_bf16(S0_[0], S0_[1]), cvt_pk_bf16(S0_[2], S0_[3]), cvt_pk_bf16(S1_[0], S1_[1]), cvt_pk_bf16(S1_[2], S1_[3])}; OUT = __builtin_bit_cast(bf16x8, w_); } while (0)
#define VLD(L_, H_, d0) do { const unsigned a0_ = vp_ + (unsigned)vpb[2 * (d0)], a1_ = vp_ + (unsigned)vpb[2 * (d0) + 1]; \
        L_[0] = vtra<0>(a0_); H_[0] = vtra<4096>(a0_); L_[1] = vtra<8192>(a0_); H_[1] = vtra<12288>(a0_); L_[2] = vtra<0>(a1_); H_[2] = vtra<4096>(a1_); L_[3] = vtra<8192>(a1_); H_[3] = vtra<12288>(a1_); } while (0)
#define LWAIT8(L_, H_) asm volatile("s_waitcnt lgkmcnt(0)" : "+v"(L_[0]), "+v"(L_[1]), "+v"(L_[2]), "+v"(L_[3]), "+v"(H_[0]), "+v"(H_[1]), "+v"(H_[2]), "+v"(H_[3]) :: "memory")
#define VFR(L_, H_, k_) (bf16x8){L_[k_][0], L_[k_][1], L_[k_][2], L_[k_][3], H_[k_][0], H_[k_][1], H_[k_][2], H_[k_][3]}
#define VMF(L_, H_, d0) do { oacc[2 * (d0)][0] = mf16(VFR(L_, H_, 0), pb00, oacc[2 * (d0)][0]); oacc[2 * (d0)][1] = mf16(VFR(L_, H_, 0), pb01, oacc[2 * (d0)][1]); \
        oacc[2 * (d0) + 1][0] = mf16(VFR(L_, H_, 2), pb00, oacc[2 * (d0) + 1][0]); oacc[2 * (d0) + 1][1] = mf16(VFR(L_, H_, 2), pb01, oacc[2 * (d0) + 1][1]); \
        oacc[2 * (d0)][0] = mf16(VFR(L_, H_, 1), pb10, oacc[2 * (d0)][0]); oacc[2 * (d0)][1] = mf16(VFR(L_, H_, 1), pb11, oacc[2 * (d0)][1]); \
        oacc[2 * (d0) + 1][0] = mf16(VFR(L_, H_, 3), pb10, oacc[2 * (d0) + 1][0]); oacc[2 * (d0) + 1][1] = mf16(VFR(L_, H_, 3), pb11, oacc[2 * (d0) + 1][1]); } while (0)
#define PV_ALL(buf_) do { const unsigned vp_ = (unsigned)(size_t)(V_lds + (buf_) * SHMV); s16x4 la_[4], ha_[4], lb_[4], hb_[4]; \
        SBAR(); VLD(la_, ha_, 0); VLD(lb_, hb_, 1); LWAIT8(la_, ha_); LWAIT8(lb_, hb_); SBAR(); \
        VMF(la_, ha_, 0); VLD(la_, ha_, 2); SBAR(); \
        VMF(lb_, hb_, 1); VLD(lb_, hb_, 3); LWAIT8(la_, ha_); LWAIT8(lb_, hb_); SBAR(); \
        VMF(la_, ha_, 2); SBAR(); VMF(lb_, hb_, 3); SBAR(); } while (0)
#define KLD(F_, Kb_, s_) do { const LAS unsigned char* a_ = (Kb_) + kswz(fr, (32 * (s_) + 8 * fq) * 2); \
        F_[0] = *(const LAS bf16x8*)a_; F_[1] = *(const LAS bf16x8*)(a_ + 4096); F_[2] = *(const LAS bf16x8*)(a_ + 8192); F_[3] = *(const LAS bf16x8*)(a_ + 12288); } while (0)
#define KMF(F_, s_) do { sa0[0] = mf16(F_[0], qf[0][s_], sa0[0]); sa0[1] = mf16(F_[0], qf[1][s_], sa0[1]); sa1[0] = mf16(F_[1], qf[0][s_], sa1[0]); sa1[1] = mf16(F_[1], qf[1][s_], sa1[1]); \
        sa2[0] = mf16(F_[2], qf[0][s_], sa2[0]); sa2[1] = mf16(F_[2], qf[1][s_], sa2[1]); sa3[0] = mf16(F_[3], qf[0][s_], sa3[0]); sa3[1] = mf16(F_[3], qf[1][s_], sa3[1]); } while (0)
#define KRLD(F_, Kb_, s_) do { const LAS unsigned char* a_ = (Kb_) + krswz(fr, 4 * (s_) + fq); \
        F_[0] = *(const LAS bf16x8*)a_; F_[1] = *(const LAS bf16x8*)(a_ + 2048); F_[2] = *(const LAS bf16x8*)(a_ + 4096); F_[3] = *(const LAS bf16x8*)(a_ + 6144); } while (0)
#define KRMF(F_, s_) do { sa0[0] = mf16(F_[0], qrf[0][s_], sa0[0]); sa0[1] = mf16(F_[0], qrf[1][s_], sa0[1]); sa1[0] = mf16(F_[1], qrf[0][s_], sa1[0]); sa1[1] = mf16(F_[1], qrf[1][s_], sa1[1]); \
        sa2[0] = mf16(F_[2], qrf[0][s_], sa2[0]); sa2[1] = mf16(F_[2], qrf[1][s_], sa2[1]); sa3[0] = mf16(F_[3], qrf[0][s_], sa3[0]); sa3[1] = mf16(F_[3], qrf[1][s_], sa3[1]); } while (0)
    const int NT = j_hi - j_lo;
    const int qlo = P0 + wid * 32;
    bf16x8 pb00 = {}, pb01 = {}, pb10 = {}, pb11 = {};
    T_DMA(j_lo, 0);
    asm volatile("s_waitcnt vmcnt(0)" ::: "memory");
    __syncthreads();
    T_DMA((j_lo + 1 < j_hi) ? j_lo + 1 : j_hi - 1, 1);
    int cur = 0;
    for (int i = 0; i < NT; ++i) {
        const int t = j_lo + i, kb = t * 64;
        const int nxt = (cur == 2) ? 0 : cur + 1, nx2 = (cur == 0) ? 2 : cur - 1;
        const int t_ld = (t + 2 < j_hi) ? t + 2 : j_hi - 1;
        const bool need = (kb <= qlo + 31) && (kb + 63 > qlo - W);
        if (need) {
        f32x4 sa0[2], sa1[2], sa2[2], sa3[2];
#pragma unroll
        for (int c = 0; c < 2; ++c) { sa0[c] = f32x4{0.f, 0.f, 0.f, 0.f}; sa1[c] = f32x4{0.f, 0.f, 0.f, 0.f}; sa2[c] = f32x4{0.f, 0.f, 0.f, 0.f}; sa3[c] = f32x4{0.f, 0.f, 0.f, 0.f}; }
        { const LAS unsigned char* Kb = K_lds + cur * SHM; bf16x8 ka_[4], kb_[4];
          SBAR(); KLD(ka_, Kb, 0); KLD(kb_, Kb, 1); SBAR();
          KMF(ka_, 0); KLD(ka_, Kb, 2); SBAR();
          KMF(kb_, 1); KLD(kb_, Kb, 3); SBAR();
          if constexpr (MODE == 1) { const LAS unsigned char* Krb = KR_lds + cur * SHMR;
              KMF(ka_, 2); KRLD(ka_, Krb, 0); SBAR();
              KMF(kb_, 3); KRLD(kb_, Krb, 1); T_DMA_K(t_ld, nx2); SBAR();
              KRMF(ka_, 0); T_DMA_V(t_ld, nx2); SBAR(); KRMF(kb_, 1); T_DMA_R(t_ld, nx2); SBAR();
          } else { KMF(ka_, 2); T_DMA_K(t_ld, nx2); SBAR(); KMF(kb_, 3); T_DMA_V(t_ld, nx2); SBAR(); } }
        if constexpr (MODE == 0) {
            const f32x4 b0 = *(const LAS f32x4*)(biasL + kb + 4 * fq), b1 = *(const LAS f32x4*)(biasL + kb + 16 + 4 * fq), b2 = *(const LAS f32x4*)(biasL + kb + 32 + 4 * fq), b3 = *(const LAS f32x4*)(biasL + kb + 48 + 4 * fq);
#pragma unroll
            for (int c = 0; c < 2; ++c) { sa0[c] += b0; sa1[c] += b1; sa2[c] += b2; sa3[c] += b3; } }
        if (kb + 63 > qlo || kb <= qlo + 31 - W) { const int dq = qpos0 - kb - 4 * fq; const float NEG = -__builtin_inff();
#pragma unroll
          for (int c = 0; c < 2; ++c)
#pragma unroll
            for (int ii = 0; ii < 4; ++ii) { const int e = dq + 16 * c - ii;
              if ((unsigned)(e) >= (unsigned)W) sa0[c][ii] = NEG;
              if ((unsigned)(e - 16) >= (unsigned)W) sa1[c][ii] = NEG;
              if ((unsigned)(e - 32) >= (unsigned)W) sa2[c][ii] = NEG;
              if ((unsigned)(e - 48) >= (unsigned)W) sa3[c][ii] = NEG; } }
        float pm0, pm1;
        { f32x4 x0 = sa0[0], x1 = sa0[1];
#pragma unroll
          for (int ii = 0; ii < 4; ++ii) { x0[ii] = fmaxf(fmaxf(x0[ii], sa1[0][ii]), fmaxf(sa2[0][ii], sa3[0][ii])); x1[ii] = fmaxf(fmaxf(x1[ii], sa1[1][ii]), fmaxf(sa2[1][ii], sa3[1][ii])); }
          pm0 = fmaxf(fmaxf(x0[0], x0[1]), fmaxf(x0[2], x0[3])); pm1 = fmaxf(fmaxf(x1[0], x1[1]), fmaxf(x1[2], x1[3])); }
        float mn0, mn1, al0, al1;
        if (__builtin_expect(__all(fmaxf(pm0 - m0, pm1 - m1) <= THR2), 1)) { mn0 = m0; mn1 = m1; al0 = 1.f; al1 = 1.f; }
        else { pm0 = xrow16_max(pm0); pm1 = xrow16_max(pm1); mn0 = fmaxf(m0, pm0); al0 = __builtin_amdgcn_exp2f(m0 - mn0); m0 = mn0; mn1 = fmaxf(m1, pm1); al1 = __builtin_amdgcn_exp2f(m1 - mn1); m1 = mn1; }
#pragma unroll
        for (int ii = 0; ii < 4; ++ii) {
            sa0[0][ii] = __builtin_amdgcn_exp2f(sa0[0][ii] - mn0); sa1[0][ii] = __builtin_amdgcn_exp2f(sa1[0][ii] - mn0); sa2[0][ii] = __builtin_amdgcn_exp2f(sa2[0][ii] - mn0); sa3[0][ii] = __builtin_amdgcn_exp2f(sa3[0][ii] - mn0);
            sa0[1][ii] = __builtin_amdgcn_exp2f(sa0[1][ii] - mn1); sa1[1][ii] = __builtin_amdgcn_exp2f(sa1[1][ii] - mn1); sa2[1][ii] = __builtin_amdgcn_exp2f(sa2[1][ii] - mn1); sa3[1][ii] = __builtin_amdgcn_exp2f(sa3[1][ii] - mn1); }
        { f32x4 y0 = (sa0[0] + sa1[0]) + (sa2[0] + sa3[0]), y1 = (sa0[1] + sa1[1]) + (sa2[1] + sa3[1]);
          l0 = l0 * al0 + ((y0[0] + y0[1]) + (y0[2] + y0[3])); l1 = l1 * al1 + ((y1[0] + y1[1]) + (y1[2] + y1[3])); }
        PK8(sa0[0], sa1[0], pb00); PK8(sa0[1], sa1[1], pb01); PK8(sa2[0], sa3[0], pb10); PK8(sa2[1], sa3[1], pb11);
        if (__any(al0 < 1.f || al1 < 1.f)) {
#pragma unroll
            for (int d = 0; d < 8; ++d) { oacc[d][0] *= al0; oacc[d][1] *= al1; } }
        PV_ALL(cur);
        } else T_DMA(t_ld, nx2);
        T_LANDED();
        __syncthreads();
        cur = nxt;
    }
    asm volatile("s_waitcnt vmcnt(0)" ::: "memory");
#undef PV_ALL
#undef VMF
#undef VFR
#undef VLD
#undef LWAIT8
#undef KLD
#undef KMF
#undef KRLD
#undef KRMF
#undef PK8
#undef T_DMA
#undef T_DMA_K
#undef T_DMA_V
#undef T_DMA_R
#undef T_LANDED
    l0 = pg8::xrow16_sum(l0); l1 = pg8::xrow16_sum(l1);
    float lsum[2] = {l0, l1}, mrow[2] = {m0, m1};
#pragma unroll
    for (int c = 0; c < 2; ++c) {
        const long qi = wid * 32 + 16 * c + fr;
        const float lse2 = mrow[c] + __builtin_amdgcn_logf(lsum[c]);
        float wgt = __builtin_amdgcn_rcpf(lsum[c]); float w2 = 0.f, w3 = 0.f;
        if constexpr (MODE == 2) { if (fq == 0) B.Lo[qi * B.ls] = lse2; }
        if constexpr (MODE == 3) { const float a2 = B.L2[qi * B.l23s], a3 = B.L3[qi * B.l23s];
            const float mx = fmaxf(lse2, fmaxf(a2, a3)); const float e1 = __builtin_amdgcn_exp2f(lse2 - mx), e2 = __builtin_amdgcn_exp2f(a2 - mx), e3 = __builtin_amdgcn_exp2f(a3 - mx);
            const float inv = __builtin_amdgcn_rcpf(e1 + e2 + e3); wgt = e1 * inv * wgt; w2 = e2 * inv; w3 = e3 * inv; }
        u32x2 w[8];
#pragma unroll
        for (int d = 0; d < 8; ++d) { f32x4 v = oacc[d][c] * wgt;
            if constexpr (MODE == 3) { const long po = qi * B.o23s + 16 * d + 4 * fq; const u32x2 u2 = *(const u32x2*)(B.O2 + po), u3 = *(const u32x2*)(B.O3 + po);
                v[0] += w2 * __uint_as_float(u2.x << 16) + w3 * __uint_as_float(u3.x << 16); v[1] += w2 * __uint_as_float(u2.x & 0xffff0000u) + w3 * __uint_as_float(u3.x & 0xffff0000u);
                v[2] += w2 * __uint_as_float(u2.y << 16) + w3 * __uint_as_float(u3.y << 16); v[3] += w2 * __uint_as_float(u2.y & 0xffff0000u) + w3 * __uint_as_float(u3.y & 0xffff0000u); }
            w[d].x = cvt_pk_bf16(v[0], v[1]); w[d].y = cvt_pk_bf16(v[2], v[3]); }
        bf16_t* Ow = B.O + qi * B.os + 8 * fq;
#pragma unroll
        for (int e = 0; e < 4; ++e) { u32x2 a = w[2 * e], b = w[2 * e + 1];
            { auto r = __builtin_amdgcn_permlane32_swap(a.x, b.x, false, false); a.x = r[0]; b.x = r[1]; }
            { auto r = __builtin_amdgcn_permlane32_swap(a.y, b.y, false, false); a.y = r[0]; b.y = r[1]; }
            { auto r = __builtin_amdgcn_permlane16_swap(a.x, b.x, false, false); a.x = r[0]; b.x = r[1]; }
            { auto r = __builtin_amdgcn_permlane16_swap(a.y, b.y, false, false); a.y = r[0]; b.y = r[1]; }
            u32x4 o4 = {a.x, a.y, b.x, b.y}; *(u32x4*)(Ow + 32 * e) = o4; } }
    __syncthreads();
}
__device__ __forceinline__ void fox_bias_table(const float* logf, int b, int h, LAS unsigned char* lds) {
    int tid_o = threadIdx.x; asm volatile("" : "+v"(tid_o));
    const int tid = tid_o, wid = tid >> 6, lane = tid & 63;
    LAS float* biasL = (LAS float*)(lds + OFF_CUM); LAS float* wsum = (LAS float*)(lds + OFF_WS);
    float v[8]; float run = 0.f;
#pragma unroll
    for (int i = 0; i < 8; ++i) { run += logf[((size_t)b * SEQ + 8 * tid + i) * 4 + h]; v[i] = run; }
    float sc = run;
#pragma unroll
    for (int o = 1; o < 64; o <<= 1) { const float n = __shfl_up(sc, o); if (lane >= o) sc += n; }
    const float excl = sc - run;
    __syncthreads();
    if (lane == 63) wsum[wid] = sc;
    __syncthreads();
    float wpre = 0.f;
    for (int w = 0; w < wid; ++w) wpre += wsum[w];
#pragma unroll
    for (int i = 0; i < 8; ++i) biasL[8 * tid + i] = -(v[i] + excl + wpre) * LOG2E;
    __syncthreads();
}
#undef SBAR
}

#define XB_TMO      128
#define XB_XCNT(j)  (256  + 64 * (j))
#define XB_XSUB(j)  (1280 + 64 * (j))
#define XB_XGEN(j)  (2304 + 64 * (j))
#define XB_TOP      3328
#define XB_TOPGEN   3392
#define XCD_BAR_WORDS 3456
#define XB_SPIN_CAP (1u << 18)
__device__ __forceinline__ unsigned xb_ld(unsigned* p)              { return __hip_atomic_load(p, __ATOMIC_RELAXED, __HIP_MEMORY_SCOPE_AGENT); }
__device__ __forceinline__ unsigned xb_add(unsigned* p, unsigned v) { return __hip_atomic_fetch_add(p, v, __ATOMIC_RELAXED, __HIP_MEMORY_SCOPE_AGENT); }
__device__ __forceinline__ unsigned xb_xcc_id() { return (unsigned)__builtin_amdgcn_s_getreg((3 << 11) | 20) & 0xFu; }
#define XB_SPIN(cond, bar) do { unsigned _sp = 0; while (cond) { __builtin_amdgcn_s_sleep(1); \
    if ((++_sp & 255u) == 0u) { if (xb_ld(&(bar)[XB_TMO])) break; if (_sp > XB_SPIN_CAP) { atomicAdd(&(bar)[XB_TMO], 1u); break; } } } } while (0)
struct XcdBarrier { unsigned* bar; unsigned x; volatile LAS unsigned* st; };
__device__ __forceinline__ XcdBarrier xcd_barrier_post(unsigned* bar, volatile LAS unsigned* st) {
    XcdBarrier b; b.bar = bar; b.x = xb_xcc_id(); b.st = st;
    if (threadIdx.x == 0) (void)xb_add(&bar[XB_XCNT(b.x)], 1u);
    return b;
}
__device__ __forceinline__ void xcd_barrier_complete(unsigned* bar, unsigned x, unsigned& nloc, unsigned& nx) {
    const unsigned G = gridDim.x * gridDim.y * gridDim.z;
    unsigned sum, cnt, mine, sp = 0u;
    for (;;) {
        sum = 0u; cnt = 0u; mine = 0u;
#pragma unroll
        for (unsigned j = 0; j < 16; ++j) { const unsigned c = xb_ld(&bar[XB_XCNT(j)]); sum += c; cnt += (c > 0u) ? 1u : 0u; mine = (j == x) ? c : mine; }
        if (sum == G) break;
        __builtin_amdgcn_s_sleep(1);
        if ((++sp & 255u) == 0u) { if (xb_ld(&bar[XB_TMO])) break; if (sp > XB_SPIN_CAP) { atomicAdd(&bar[XB_TMO], 1u); break; } }
    }
    nloc = mine > 0u ? mine : 1u; nx = cnt > 0u ? cnt : 1u;
}
__device__ __forceinline__ void xcd_barrier(const XcdBarrier& b) {
    asm volatile("s_waitcnt vmcnt(0)" ::: "memory");
    __syncthreads();
    if (threadIdx.x == 0) {
        unsigned* bar = b.bar;
        __builtin_amdgcn_s_waitcnt(0);
        unsigned nloc = b.st[0], nx = b.st[1];
        if (nloc == 0u) { xcd_barrier_complete(bar, b.x, nloc, nx); b.st[0] = nloc; b.st[1] = nx; }
        const unsigned old = xb_add(&bar[XB_XSUB(b.x)], 1u);
        const unsigned gen = old / nloc;
        if (old + 1u == (gen + 1u) * nloc) {
            __builtin_amdgcn_fence(__ATOMIC_RELEASE, "agent");
            asm volatile("s_waitcnt vmcnt(0)" ::: "memory");
            const unsigned og = xb_add(&bar[XB_TOP], 1u);
            const unsigned tg = og / nx;
            if (og + 1u == (tg + 1u) * nx) xb_add(&bar[XB_TOPGEN], 1u);
            else XB_SPIN(xb_ld(&bar[XB_TOPGEN]) == tg, bar);
            __builtin_amdgcn_fence(__ATOMIC_ACQUIRE, "agent");
            xb_add(&bar[XB_XGEN(b.x)], 1u);
            asm volatile("s_waitcnt vmcnt(0)" ::: "memory");
        } else {
            XB_SPIN(xb_ld(&bar[XB_XGEN(b.x)]) == gen, bar);
            __builtin_amdgcn_fence(__ATOMIC_ACQUIRE, "agent");
            asm volatile("s_waitcnt vmcnt(0)" ::: "memory");
        }
    }
    __syncthreads();
}

__device__ __forceinline__ unsigned f2bf(float f) { unsigned u = __builtin_bit_cast(unsigned, f); return (u + 0x7fffu + ((u >> 16) & 1u)) >> 16; }
__device__ __forceinline__ unsigned pk2(float lo, float hi) { return f2bf(lo) | (f2bf(hi) << 16); }
__device__ __forceinline__ void cvt_item(const float* W, int ldw, const float* gain, bf16_t* WT, int K, int n0, int k0, int src4, LAS float* scr, int lane) {
    const int kq = lane >> 3, c4 = lane & 7;
    f32x4 v[8]; float g[8];
#pragma unroll
    for (int i = 0; i < 8; ++i) { v[i] = (src4 >= 0) ? *(const f32x4*)(W + (size_t)(k0 + 8 * i + kq) * ldw + src4) : (f32x4){0.f, 0.f, 0.f, 0.f}; g[i] = gain ? gain[k0 + 8 * i + kq] : 1.0f; }
#pragma unroll
    for (int i = 0; i < 8; ++i) { LAS float* d = scr + (8 * i + kq) * 33 + 4 * c4; const f32x4 w = v[i] * g[i]; d[0] = w[0]; d[1] = w[1]; d[2] = w[2]; d[3] = w[3]; }
    LDS_WAIT(); asm volatile("" ::: "memory");
    const int c = lane & 7;
#pragma unroll
    for (int j = 0; j < 4; ++j) { const int n = (lane >> 3) + 8 * j; const LAS float* s = scr + (8 * c) * 33 + n;
        u32x4 o; o.x = pk2(s[0 * 33], s[1 * 33]); o.y = pk2(s[2 * 33], s[3 * 33]); o.z = pk2(s[4 * 33], s[5 * 33]); o.w = pk2(s[6 * 33], s[7 * 33]);
        *(u32x4*)(WT + (size_t)(n0 + n) * K + k0 + 8 * c) = o; }
    LDS_WAIT(); asm volatile("" ::: "memory");
}
__device__ __forceinline__ int map_win(int n) {
    if (n < 1536) return n;
    if (n < 2560) return 1540 + (n - 1536);
    if (n < 4096) return 2628 + (n - 2560);
    if (n < 4160) { const int p = n - 4096, wc = p >> 5, nn = (p >> 4) & 1, r = p & 15; return 2564 + 16 * wc + r + 32 * nn; }
    if (n < 4164) return 1536 + (n - 4160);
    return -1;
}
__device__ __forceinline__ int map_uq(int n) {
    if (n < 1024) return (n >> 7) * 192 + (n & 127);
    const int p = n - 1024, head = p >> 6, pp = p & 63, w1 = pp >> 5, nn = (pp >> 4) & 1, r = pp & 15;
    return head * 192 + 128 + 16 * w1 + r + 32 * nn;
}
__device__ __forceinline__ void sincos_acc(float ang, float& s, float& c) {
    const double a = (double)ang; const double k = rint(a * 0.63661977236758134308);
    double r = fma(-k, 1.57079632679489655800e+00, a); r = fma(-k, 6.12323399573676603587e-17, r);
    const double r2 = r * r;
    double sp = -2.50521083854417187751e-08; sp = fma(sp, r2, 2.75573192239858906526e-06); sp = fma(sp, r2, -1.98412698412698412698e-04); sp = fma(sp, r2, 8.33333333333333333333e-03); sp = fma(sp, r2, -1.66666666666666666667e-01);
    const double sn = fma(r * r2, sp, r);
    double cp = 2.08767569878680989792e-09; cp = fma(cp, r2, -2.75573192239858906526e-07); cp = fma(cp, r2, 2.48015873015873015873e-05); cp = fma(cp, r2, -1.38888888888888888889e-03); cp = fma(cp, r2, 4.16666666666666666667e-02); cp = fma(cp, r2, -0.5);
    const double cs = fma(r2, cp, 1.0);
    const int q = ((int)k) & 3;
    const double ss = (q == 0) ? sn : (q == 1) ? cs : (q == 2) ? -sn : -cs;
    const double cc = (q == 0) ? cs : (q == 1) ? -sn : (q == 2) ? -cs : sn;
    s = (float)ss; c = (float)cc;
}

constexpr int NWAVES = 8;
#ifndef MK_SITE_MASK
#define MK_SITE_MASK 0xFFF
#endif
#ifndef MK_REP_MASK
#define MK_REP_MASK 0x0
#define MK_REP_N 1
#endif
#ifndef MK_EPI_REP
#define MK_EPI_REP 1
#endif
#define NREP(i) ((((MK_REP_MASK) >> (i)) & 1) ? MK_REP_N : 1)
#define REP(i) for (int rep = 0; rep < NREP(i); ++rep)
constexpr int RING_BYTES = 131072, MISC_OFF = RING_BYTES + 320, LDS_BYTES = 147456;
constexpr int NPHASE = 2 + 8 * DEPTH;

struct Args { const float* in[18]; float* out; unsigned char* ws; int ph_lo, ph_hi, use_bar, pad; };

__global__ void __launch_bounds__(NWAVES * 64, 2) mk_fwd(Args args) {
    extern __shared__ __attribute__((aligned(16))) unsigned char lds_raw[];
    LAS unsigned char* lds = (LAS unsigned char*)lds_raw;
    volatile LAS unsigned* MISC = (volatile LAS unsigned*)(lds + MISC_OFF);
    const int G = gridDim.x; const int bx = blockIdx.x; const int vcu = (G % 8 == 0) ? (bx % 8) * (G / 8) + bx / 8 : bx;
    unsigned char* ws = args.ws;
    unsigned* ctl = (unsigned*)(ws + WS_CTL);
    for (int u = threadIdx.x; u < (LDS_BYTES - RING_BYTES) / 4; u += NWAVES * 64) ((LAS unsigned*)(lds + RING_BYTES))[u] = 0u;
    __syncthreads();
    XcdBarrier bar; bar.bar = ctl + CW_BAR; bar.x = 0; bar.st = nullptr;
    if (args.use_bar) bar = xcd_barrier_post(ctl + CW_BAR, MISC + 8);
    const int lo = args.ph_lo, hi = args.ph_hi;
#define IN(k) (lo <= (k) && (k) < hi)
#define EN(i) (((MK_SITE_MASK) >> (i)) & 1)
#define SEAM(k) do { if (args.use_bar && IN((k) + 1)) xcd_barrier(bar); } while (0)

    const float* x_in = args.in[0];
    float* xres = args.out;
#define WSL GAS unsigned char* wsl = (GAS unsigned char*)ws; asm volatile("" : "+s"(wsl))
#define XB ((bf16_t*)(GAS bf16_t*)(wsl + WS_XB))
#define ACT ((bf16_t*)(GAS bf16_t*)(wsl + WS_BIG))
#define P ((bf16_t*)(GAS bf16_t*)(wsl + WS_P))
#define KR ((bf16_t*)(GAS bf16_t*)(wsl + WS_KR))
#define QBN ((bf16_t*)(GAS bf16_t*)(wsl + WS_QBN))
#define QBR ((bf16_t*)(GAS bf16_t*)(wsl + WS_QBR))
#define KVB ((bf16_t*)(GAS bf16_t*)(wsl + WS_KVB))
#define MIX ((bf16_t*)(GAS bf16_t*)(wsl + WS_MIX))
#define DILO ((bf16_t*)(GAS bf16_t*)(wsl + WS_DILO))
#define SSQ ((float*)(GAS float*)(wsl + WS_SSQ))
#define SSQQ ((float*)(GAS float*)(wsl + WS_SSQQ))
#define SSQKV ((float*)(GAS float*)(wsl + WS_SSQKV))
#define LOGF ((float*)(GAS float*)(wsl + WS_LOGF))
#define LSE ((float*)(GAS float*)(wsl + WS_LSE))
#define COSM ((float*)(GAS float*)(wsl + WS_COSM))
#define SINM ((float*)(GAS float*)(wsl + WS_SINM))
#define COSP ((float*)(GAS float*)(wsl + WS_COSP))
#define SINP ((float*)(GAS float*)(wsl + WS_SINP))
    const int NGW = G * NWAVES;
#define SITE_LANE int tid_o = threadIdx.x; asm volatile("" : "+v"(tid_o)); const int tid = tid_o, lane = tid & 63, wave = __builtin_amdgcn_readfirstlane(tid >> 6), gw = vcu * NWAVES + wave; (void)tid; (void)lane; (void)gw

    if (EN(0) && IN(0)) { WSL; SITE_LANE;
        REP(0) {
        LAS float* scr = (LAS float*)(lds + wave * 16384);
        constexpr int I_GU = (DM / 64) * (NGU / 32), I_DN = (FF / 64) * (DM / 32), I_IN = (DM / 64) * (INP / 32), I_UQ = (512 / 64) * (1536 / 32), I_UKV = (512 / 64) * (2048 / 32), I_OUT = (DM / 64) * (DM / 32);
        constexpr int I_LAYER = 2 * I_GU + 2 * I_DN + I_IN + I_UQ + I_UKV + I_OUT;
        for (int it = gw; it < DEPTH * I_LAYER; it += NGW) {
            const int l = it / I_LAYER; int r = it - l * I_LAYER;
            unsigned char* wl = ws + WS_W + (size_t)l * W_LAYER;
            const int nl = 4 * (lane & 7);
            if (r < 2 * I_GU) { const int f2 = r >= I_GU; if (f2) r -= I_GU; const int nblk = NGU / 32, kb = r / nblk, nb = r % nblk, n0 = 32 * nb;
                const int tile = n0 >> 8, within = n0 & 255; const bool up = within >= 128; const int col = tile * 128 + (within & 127) + nl;
                const float* W = args.in[(f2 ? 14 : 2) + (up ? 1 : 0)] + (size_t)l * DM * FF; const float* gain = args.in[f2 ? 13 : 1] + (size_t)l * DM;
                cvt_item(W, FF, gain, (bf16_t*)(wl + (f2 ? WO_GU2 : WO_GU1)), DM, n0, 64 * kb, col, scr, lane); continue; }
            r -= 2 * I_GU;
            if (r < 2 * I_DN) { const int f2 = r >= I_DN; if (f2) r -= I_DN; const int nblk = DM / 32, kb = r / nblk, nb = r % nblk, n0 = 32 * nb;
                const float* W = args.in[f2 ? 16 : 4] + (size_t)l * FF * DM;
                cvt_item(W, DM, nullptr, (bf16_t*)(wl + (f2 ? WO_DN2 : WO_DN1)), FF, n0, 64 * kb, n0 + nl, scr, lane); continue; }
            r -= 2 * I_DN;
            if (r < I_IN) { const int nblk = INP / 32, kb = r / nblk, nb = r % nblk, n0 = 32 * nb;
                cvt_item(args.in[6] + (size_t)l * DM * IN_W, IN_W, args.in[5] + (size_t)l * DM, (bf16_t*)(wl + WO_IN), DM, n0, 64 * kb, map_win(n0 + nl), scr, lane); continue; }
            r -= I_IN;
            if (r < I_UQ) { const int nblk = 1536 / 32, kb = r / nblk, nb = r % nblk, n0 = 32 * nb;
                cvt_item(args.in[10] + (size_t)l * 512 * 1536, 1536, args.in[8] + (size_t)l * 512, (bf16_t*)(wl + WO_UQ), 512, n0, 64 * kb, map_uq(n0 + nl), scr, lane); continue; }
            r -= I_UQ;
            if (r < I_UKV) { const int nblk = 2048 / 32, kb = r / nblk, nb = r % nblk, n0 = 32 * nb;
                cvt_item(args.in[11] + (size_t)l * 512 * 2048, 2048, args.in[9] + (size_t)l * 512, (bf16_t*)(wl + WO_UKV), 512, n0, 64 * kb, n0 + nl, scr, lane); continue; }
            r -= I_UKV;
            { const int nblk = DM / 32, kb = r / nblk, nb = r % nblk, n0 = 32 * nb;
              cvt_item(args.in[12] + (size_t)l * DM * DM, DM, nullptr, (bf16_t*)(wl + WO_OUT), DM, n0, 64 * kb, n0 + nl, scr, lane); }
        }
        for (int i = bx * (NWAVES * 64) + tid; i < SEQ * 48; i += G * NWAVES * 64) {
            const int s = i / 48, j = i % 48; float sn, cs;
            if (j < 32) { const float inv = 1.0f / powf(500000.0f, (float)(2 * j) / 64.0f); sincos_acc((float)s * inv, sn, cs); COSM[s * 32 + j] = cs; SINM[s * 32 + j] = sn; }
            else { const int jj = j - 32; const float inv = 1.0f / powf(500000.0f, (float)(2 * jj) / 32.0f); sincos_acc((float)s * inv, sn, cs); COSP[s * 16 + jj] = cs; SINP[s * 16 + jj] = sn; }
        }
        for (int m = gw; m < M; m += NGW) { const f32x4* xr = (const f32x4*)(x_in + (size_t)m * DM) + lane; float s = 0.f;
            u32x2* o8 = (u32x2*)(XB + (size_t)m * DM) + lane;
#pragma unroll
            for (int j = 0; j < 8; ++j) { const f32x4 v = xr[64 * j]; s += (v[0] * v[0] + v[1] * v[1]) + (v[2] * v[2] + v[3] * v[3]); u32x2 w; w.x = cvt_pk_bf16(v[0], v[1]); w.y = cvt_pk_bf16(v[2], v[3]); o8[64 * j] = w; }
#pragma unroll
            for (int o = 1; o < 64; o <<= 1) s += __shfl_xor(s, o);
            if (lane < 32) SSQ[(size_t)m * 32 + lane] = (lane == 0) ? s : 0.f; }
        }
        VM_WAIT(); __syncthreads();
        SEAM(0);
    }

    for (int l = 0; l < DEPTH; ++l) {
        const int pb = 1 + 8 * l;
        unsigned char* wl = ws + WS_W + (size_t)l * W_LAYER;
        for (int half = 0; half < 2; ++half) {
        if (EN(1) && IN(pb + 6 * half)) { WSL; pg8::Gemm g{XB, (const bf16_t*)(wl + (half ? WO_GU2 : WO_GU1)), DM, DM, M, NGU, DM}; pg8::EpiGateUp E{wsl}; REP(1) { pg8::StaticOrder S; S.init(M, NGU, G, bx); pg8::gemm_phase<pg8::EpiGateUp, true>(lds, g, S, E); } SEAM(pb + 6 * half); }
        if (EN(2) && IN(pb + 6 * half + 1)) { WSL; pg8::Gemm g{ACT, (const bf16_t*)(wl + (half ? WO_DN2 : WO_DN1)), 64, FF, M, DM, FF, 256 * 64 * 2, (FF / 64) * 256 * 64 * 2}; REP(2) { pg8::StaticOrder S; S.init(M, DM, G, bx, 4); pg8::EpiResid E{XB, (rep + 1 < NREP(2)) ? (bf16_t*)(GAS bf16_t*)(wsl + WS_KVB) : XB, wsl, 0.5f}; pg8::gemm_phase<pg8::EpiResid, true>(lds, g, S, E); } SEAM(pb + 6 * half + 1); }
        if (half) break;
        if (EN(3) && IN(pb + 2)) { WSL; pg8::Gemm g{XB, (const bf16_t*)(wl + WO_IN), DM, DM, M, INP, DM}; pg8::EpiWin E{wsl, args.in[7] + l * 4};
            REP(3) { pg8::StaticOrder S; S.init(M, INP, G, bx); pg8::gemm_phase<pg8::EpiWin, true>(lds, g, S, E); } SEAM(pb + 2); }
        if (IN(pb + 3)) {
            if (EN(4)) { WSL; pg8::Gemm g{P + PC_CQ, (const bf16_t*)(wl + WO_UQ), PP, 512, M, 1536, 512}; pg8::EpiUq E{wsl}; REP(4) { pg8::StaticOrder S; S.init(M, 1536, G, bx); pg8::gemm_phase<pg8::EpiUq, true>(lds, g, S, E); } }
            if (EN(5)) { WSL; pg8::Gemm g{P + PC_CKV, (const bf16_t*)(wl + WO_UKV), PP, 512, M, 2048, 512}; pg8::EpiUkv E{wsl}; REP(5) { pg8::StaticOrder S; S.init(M, 2048, G, bx); pg8::gemm_phase<pg8::EpiUkv, true>(lds, g, S, E); } }
            if (EN(6)) REP(6) for (int it = vcu; it < 1024; it += G) { WSL;
                const int br = it >> 9, i2 = it & 511, bh = i2 >> 4, sub = i2 & 15; const int b = bh >> 2, h = bh & 3;
                const int d = br ? 16 : 4; const int res = br ? sub : (sub >> 2), qb = br ? 0 : (sub & 3);
                const size_t row0 = (size_t)b * SEQ + res;
                att::Blk B{}; B.qs = (long)PP * d; B.ks = B.qs; B.vs = B.qs; B.os = 512L * d; B.ls = 4L * d; B.P0 = qb * 256; B.W = 129;
                B.Q = P + (row0 + (size_t)qb * 256 * d) * PP + PC_DQ + h * HD; B.K = P + row0 * PP + PC_DK + h * HD; B.V = P + row0 * PP + PC_DV + h * HD;
                B.O = DILO + (size_t)br * M * 512 + (row0 + (size_t)qb * 256 * d) * 512 + h * HD; B.Lo = LSE + (size_t)br * M * 4 + (row0 + (size_t)qb * 256 * d) * 4 + h;
                att::attn_block<2>(B, lds);
            }
            SEAM(pb + 3);
        }
        if (IN(pb + 4)) {
            if (EN(7)) REP(7) for (int it = vcu; it < 256; it += G) { WSL; const int bh = it >> 3, x = it & 7, b = bh >> 2, h = bh & 3;
                att::fox_bias_table(LOGF, b, h, lds);
                for (int pass = 0; pass < 2; ++pass) { const int qb = pass ? 15 - x : x; const size_t row0 = (size_t)b * SEQ;
                    att::Blk B{}; B.qs = PP; B.ks = PP; B.vs = PP; B.os = 2048; B.P0 = qb * 256; B.W = 1 << 20;
                    B.Q = P + (row0 + (size_t)qb * 256) * PP + PC_FQ + h * HD; B.K = P + row0 * PP + PC_FK + h * HD; B.V = P + row0 * PP + PC_FV + h * HD;
                    B.O = MIX + (row0 + (size_t)qb * 256) * 2048 + h * HD;
                    att::attn_block<0>(B, lds); } }
            if (EN(8)) REP(8) for (int it = vcu; it < 512; it += G) { WSL; const int bh = it >> 3, x = it & 7, b = bh >> 3, h = bh & 7;
                for (int pass = 0; pass < 2; ++pass) { const int qb = pass ? 15 - x : x; const size_t row0 = (size_t)b * SEQ;
                    att::Blk B{}; B.qs = 1024; B.qrs = 512; B.ks = 2048; B.krs = 64; B.vs = 2048; B.os = 2048; B.P0 = qb * 256; B.W = 1 << 20;
                    B.Q = QBN + (row0 + (size_t)qb * 256) * 1024 + h * HD; B.Qr = QBR + (row0 + (size_t)qb * 256) * 512 + h * 64;
                    B.K = KVB + row0 * 2048 + h * 256; B.Kr = KR + row0 * 64; B.V = KVB + row0 * 2048 + h * 256 + HD;
                    B.O = MIX + (row0 + (size_t)qb * 256) * 2048 + 512 + h * HD;
                    att::attn_block<1>(B, lds); } }
            if (EN(9)) REP(9) for (int it = vcu; it < 512; it += G) { WSL; const int bh = it >> 4, qb = it & 15, b = bh >> 2, h = bh & 3; const size_t row0 = (size_t)b * SEQ, rq = row0 + (size_t)qb * 256;
                att::Blk B{}; B.qs = PP; B.ks = PP; B.vs = PP; B.os = 2048; B.P0 = qb * 256; B.W = 129;
                B.Q = P + rq * PP + PC_DQ + h * HD; B.K = P + row0 * PP + PC_DK + h * HD; B.V = P + row0 * PP + PC_DV + h * HD;
                B.O = MIX + rq * 2048 + 1536 + h * HD;
                B.O2 = DILO + rq * 512 + h * HD; B.O3 = DILO + (size_t)M * 512 + rq * 512 + h * HD; B.L2 = LSE + rq * 4 + h; B.L3 = LSE + (size_t)M * 4 + rq * 4 + h; B.o23s = 512; B.l23s = 4;
                att::attn_block<3>(B, lds); }
            SEAM(pb + 4);
        }
        if (EN(10) && IN(pb + 5)) { WSL; pg8::Gemm g{MIX, (const bf16_t*)(wl + WO_OUT), DM, DM, M, DM, DM}; REP(10) { pg8::StaticOrder S; S.init(M, DM, G, bx, 4); pg8::EpiResid E{XB, (rep + 1 < NREP(10)) ? (bf16_t*)(GAS bf16_t*)(wsl + WS_P) : XB, wsl, 1.0f}; pg8::gemm_phase<pg8::EpiResid, true>(lds, g, S, E); } SEAM(pb + 5); }
        }
    }
    if (EN(11) && IN(NPHASE - 1)) { WSL; SITE_LANE;
        const float* gf = args.in[17];
        for (int m = gw; m < M; m += NGW) { float s = (lane < 32) ? SSQ[(size_t)m * 32 + lane] : 0.f;
#pragma unroll
            for (int o = 1; o < 64; o <<= 1) s += __shfl_xor(s, o);
            const float r = __builtin_amdgcn_rsqf(s * (1.0f / DM) + EPS);
            const u32x4* xr = (const u32x4*)(XB + (size_t)m * DM) + lane; f32x4* orow = (f32x4*)(xres + (size_t)m * DM); const f32x4* gr = (const f32x4*)gf;
#pragma unroll
            for (int j = 0; j < 4; ++j) { const u32x4 b = xr[64 * j]; const int c = (64 * j + lane) * 2;
                f32x4 v0, v1; v0[0] = __uint_as_float(b.x << 16); v0[1] = __uint_as_float(b.x & 0xffff0000u); v0[2] = __uint_as_float(b.y << 16); v0[3] = __uint_as_float(b.y & 0xffff0000u);
                v1[0] = __uint_as_float(b.z << 16); v1[1] = __uint_as_float(b.z & 0xffff0000u); v1[2] = __uint_as_float(b.w << 16); v1[3] = __uint_as_float(b.w & 0xffff0000u);
                orow[c] = v0 * r * gr[c]; orow[c + 1] = v1 * r * gr[c + 1]; } }
    }
#undef IN
#undef SEAM
#undef EN
}

#ifndef MK_ONE_LAUNCH
#define MK_ONE_LAUNCH 1
#endif
extern "C" void kernel_launch(void* const* d_in, const int* in_sizes, int n_in, void* d_out, int out_size, void* d_ws, size_t ws_size, hipStream_t stream) {
    static int grid = 0;
    if (grid == 0) {
        if (n_in != 18 || in_sizes[0] != M * DM || out_size != M * DM || ws_size < WS_END) {
            fprintf(stderr, "kernel_launch: shape/workspace mismatch (n_in %d, in0 %d, out %d, ws %zu, need %zu)\n", n_in, n_in > 0 ? in_sizes[0] : -1, out_size, ws_size, (size_t)WS_END); grid = -1; return; }
        int dev = 0, cus = 0;
        if (hipGetDevice(&dev) != hipSuccess || hipDeviceGetAttribute(&cus, hipDeviceAttributeMultiprocessorCount, dev) != hipSuccess) { grid = -1; return; }
        if (hipFuncSetAttribute((const void*)mk_fwd, hipFuncAttributeMaxDynamicSharedMemorySize, LDS_BYTES) != hipSuccess) { fprintf(stderr, "kernel_launch: hipFuncSetAttribute failed\n"); grid = -1; return; }
        int per_cu = 0;
        if (hipOccupancyMaxActiveBlocksPerMultiprocessor(&per_cu, (const void*)mk_fwd, NWAVES * 64, LDS_BYTES) != hipSuccess || per_cu < 1) fprintf(stderr, "kernel_launch: occupancy query says %d\n", per_cu);
        (void)hipGetLastError();
        grid = cus;
    }
    if (grid < 0) return;
    if (hipMemsetAsync((char*)d_ws + WS_CTL, 0, CTL_ZERO_BYTES, stream) != hipSuccess) return;
    Args a{};
    for (int i = 0; i < 18; ++i) a.in[i] = (const float*)d_in[i];
    a.out = (float*)d_out; a.ws = (unsigned char*)d_ws;
#if MK_ONE_LAUNCH
    a.ph_lo = 0; a.ph_hi = NPHASE; a.use_bar = 1;
    hipLaunchKernelGGL(mk_fwd, dim3(grid), dim3(NWAVES * 64), LDS_BYTES, stream, a);
#else
    for (int p = 0; p < NPHASE; ++p) { a.ph_lo = p; a.ph_hi = p + 1; a.use_bar = 0;
        hipLaunchKernelGGL(mk_fwd, dim3(grid), dim3(NWAVES * 64), LDS_BYTES, stream, a); }
#endif
}
```
